# Optimizing an MI355X kernel written in HIP

```python
import jax, jax.numpy as jnp
from jax import lax
import numpy as np

D_MODEL = 1024
BATCH = 16
SEQ = 256
DEPTH = 4
DEC_BATCH = 2
DEC_SEQ = 1024
PAST_LEN = 512

GRID_W = 64
N_DIR = 2
N_BRANCH = 3
N_ADA = 9
D_FF = 2816
CONV_K = 3
EPS = 1e-6

S5_WIDTH = 512
S5_GROUP = 16
S5_GROUPS = S5_WIDTH // S5_GROUP
S5_STATE = 64

SSD_WIDTH = 512
SSD_HEADDIM = 64
SSD_HEADS = SSD_WIDTH // SSD_HEADDIM
SSD_GROUPS = 2
SSD_STATE = 64
SSD_CHUNK = 128
SSD_CONV_DIM = SSD_WIDTH + 2 * SSD_GROUPS * SSD_STATE

DN_HEADS = 4
DN_DK = 128
DN_DV = 128
DN_QK = DN_HEADS * DN_DK
DN_V = DN_HEADS * DN_DV
DN_CHUNK = 64
DN_CONV_DIM = 2 * DN_QK + DN_V

IN_SEGMENTS = (S5_WIDTH, SSD_WIDTH, SSD_CONV_DIM, N_DIR * SSD_HEADS, DN_CONV_DIM, N_DIR * DN_HEADS, N_DIR * DN_HEADS, DN_V, N_BRANCH * D_MODEL)
IN_WIDTH = sum(IN_SEGMENTS)
IN_SPLITS = tuple(int(s) for s in np.cumsum(IN_SEGMENTS)[:-1])

kernel_name = 'hybrid_s5_ssd_deltanet_diffusion_step'


def _rmsnorm(x, g):
    xf = x.astype(jnp.float32)
    y = xf * lax.rsqrt(jnp.mean(xf * xf, axis=-1, keepdims=True) + EPS)
    return (y * g.astype(jnp.float32)).astype(x.dtype)


def _l2norm(x):
    return x * lax.rsqrt(jnp.sum(x * x, axis=-1, keepdims=True) + EPS)


def _rev(t):
    return jnp.flip(t, axis=1)


def _short_conv(x, w, grid):
    bsz, seq, ch = x.shape
    width = GRID_W if grid else seq
    rows = seq // width
    pad = CONV_K // 2
    xp = jnp.pad(x.reshape(bsz, rows, width, ch), ((0, 0), (0, 0), (pad, pad), (0, 0)))
    y = xp[:, :, 0:width] * w[0]
    for k in range(1, CONV_K):
        y = y + xp[:, :, k:k + width] * w[k]
    return y.reshape(bsz, seq, ch)


def _complex_affine_combine(e1, e2):
    a1r, a1i, b1r, b1i = e1
    a2r, a2i, b2r, b2i = e2
    return (a2r * a1r - a2i * a1i,
            a2r * a1i + a2i * a1r,
            a2r * b1r - a2i * b1i + b2r,
            a2r * b1i + a2i * b1r + b2i)


def _s5_scan(u, lam_re, lam_im, log_dt, b_re, b_im, c_re, c_im, h0_re, h0_im):
    dt = jnp.exp(log_dt)[:, None]
    mag = jnp.exp(lam_re * dt)
    lb_re = mag * jnp.cos(lam_im * dt)
    lb_im = mag * jnp.sin(lam_im * dt)
    den = lam_re * lam_re + lam_im * lam_im
    cr = ((lb_re - 1.0) * lam_re + lb_im * lam_im) / den
    ci = (lb_im * lam_re - (lb_re - 1.0) * lam_im) / den
    bb_re = cr[..., None] * b_re - ci[..., None] * b_im
    bb_im = cr[..., None] * b_im + ci[..., None] * b_re
    bu_re = jnp.einsum('blgi,gpi->blgp', u, bb_re)
    bu_im = jnp.einsum('blgi,gpi->blgp', u, bb_im)
    bu_re = bu_re.at[:, 0].add(lb_re * h0_re - lb_im * h0_im)
    bu_im = bu_im.at[:, 0].add(lb_re * h0_im + lb_im * h0_re)
    a_re = jnp.broadcast_to(lb_re, bu_re.shape)
    a_im = jnp.broadcast_to(lb_im, bu_im.shape)
    _, _, h_re, h_im = lax.associative_scan(_complex_affine_combine, (a_re, a_im, bu_re, bu_im), axis=1)
    y = jnp.einsum('blgp,gip->blgi', h_re, c_re) - jnp.einsum('blgp,gip->blgi', h_im, c_im)
    return y, h_re[:, -1], h_im[:, -1]


def _ssd_scan(x, dt, a, bm, cm, h0):
    bsz, seq, nh, hp = x.shape
    ns = bm.shape[-1]
    nc = seq // SSD_CHUNK
    xc = (x * dt[..., None]).reshape(bsz, nc, SSD_CHUNK, nh, hp)
    bc = bm.reshape(bsz, nc, SSD_CHUNK, nh, ns)
    cc = cm.reshape(bsz, nc, SSD_CHUNK, nh, ns)
    acum = jnp.cumsum((dt * a).reshape(bsz, nc, SSD_CHUNK, nh), axis=2)
    idx = jnp.arange(SSD_CHUNK)
    lower = (idx[:, None] >= idx[None, :])[None, None, :, :, None]
    seg = jnp.exp(jnp.where(lower, acum[:, :, :, None, :] - acum[:, :, None, :, :], -jnp.inf))
    scores = jnp.einsum('bcihn,bcjhn->bcijh', cc, bc) * seg
    y_diag = jnp.einsum('bcijh,bcjhp->bcihp', scores, xc)
    to_end = jnp.exp(acum[:, :, -1:, :] - acum)
    chunk_states = jnp.einsum('bcjhn,bcjh,bcjhp->bchpn', bc, to_end, xc)
    chunk_decay = jnp.exp(acum[:, :, -1, :])

    def step(h, inp):
        s, d = inp
        return h * d[:, :, None, None] + s, h

    h_final, h_enter = lax.scan(step, h0, (jnp.moveaxis(chunk_states, 1, 0), jnp.moveaxis(chunk_decay, 1, 0)))
    h_enter = jnp.moveaxis(h_enter, 0, 1)
    y_off = jnp.einsum('bcihn,bchpn,bcih->bcihp', cc, h_enter, jnp.exp(acum))
    return (y_diag + y_off).reshape(bsz, seq, nh, hp), h_final


def _gated_delta(q, k, v, beta, g, h0):
    bsz, seq, nh, dk = q.shape
    dv = v.shape[-1]
    nc = seq // DN_CHUNK

    def chunks(t):
        t = jnp.moveaxis(t, 2, 1)
        return t.reshape(t.shape[0], t.shape[1], nc, DN_CHUNK, *t.shape[3:])

    q, k, v, beta, g = chunks(q), chunks(k), chunks(v), chunks(beta), chunks(g)
    gc = jnp.cumsum(g, axis=-1)
    idx = jnp.arange(DN_CHUNK)
    incl = idx[:, None] >= idx[None, :]
    strict = idx[:, None] > idx[None, :]
    decay = jnp.exp(jnp.where(incl, gc[..., :, None] - gc[..., None, :], -jnp.inf))
    kb = k * beta[..., None]
    m = jnp.where(strict, jnp.einsum('bhnid,bhnjd->bhnij', kb, k) * decay, 0.0)
    a_mat = jnp.eye(DN_CHUNK, dtype=m.dtype) + m
    u = lax.linalg.triangular_solve(a_mat, v * beta[..., None], left_side=True, lower=True)
    w = lax.linalg.triangular_solve(a_mat, kb * jnp.exp(gc)[..., None], left_side=True, lower=True)
    attn = jnp.einsum('bhnid,bhnjd->bhnij', q, k) * decay

    def step(s, inp):
        q_c, k_c, u_c, w_c, attn_c, gc_c = inp
        v_new = u_c - jnp.einsum('bhcd,bhde->bhce', w_c, s)
        o = (jnp.einsum('bhcd,bhde->bhce', q_c * jnp.exp(gc_c)[..., None], s)
             + jnp.einsum('bhij,bhje->bhie', attn_c, v_new))
        g_last = gc_c[..., -1]
        s = (s * jnp.exp(g_last)[..., None, None]
             + jnp.einsum('bhcd,bhce->bhde', k_c * jnp.exp(g_last[..., None] - gc_c)[..., None], v_new))
        return s, o

    xs = tuple(jnp.moveaxis(t, 2, 0) for t in (q, k, u, w, attn, gc))
    s_final, o = lax.scan(step, h0, xs)
    o = jnp.moveaxis(o, 0, 2).reshape(bsz, nh, seq, dv)
    return jnp.moveaxis(o, 1, 2), s_final


def _mixer_block(h, p, init, grid):
    f32 = jnp.float32
    bsz, seq, _ = h.shape
    proj = (h @ p['w_in']).astype(f32)
    u_s5, z, xbc, dt_raw, qkv, beta_raw, a_raw, dn_gate, gate_raw = jnp.split(proj, IN_SPLITS, axis=-1)

    u = u_s5.reshape(bsz, seq, S5_GROUPS, S5_GROUP)
    s5p = [p[n].astype(f32) for n in ('s5_lam_re', 's5_lam_im', 's5_log_dt', 's5_b_re', 's5_b_im', 's5_c_re', 's5_c_im')]
    h0r = init['s5_re'].astype(f32)
    h0i = init['s5_im'].astype(f32)
    y_f, sfr, sfi = _s5_scan(u, *[t[0] for t in s5p], h0r[:, 0], h0i[:, 0])
    y_b, sbr, sbi = _s5_scan(_rev(u), *[t[1] for t in s5p], h0r[:, 1], h0i[:, 1])
    y_s5 = (y_f + _rev(y_b) + p['s5_d'].astype(f32).reshape(S5_GROUPS, S5_GROUP) * u).reshape(bsz, seq, S5_WIDTH)
    g_s5 = jax.nn.gelu(y_s5)
    br_a = (g_s5 @ p['s5_glu'][0]) * jax.nn.sigmoid(g_s5 @ p['s5_glu'][1])

    xbc = jax.nn.silu(_short_conv(xbc, p['ssd_conv_w'].astype(f32), grid) + p['ssd_conv_b'].astype(f32))
    xs, bm, cm = jnp.split(xbc, (SSD_WIDTH, SSD_WIDTH + SSD_GROUPS * SSD_STATE), axis=-1)
    xs = xs.reshape(bsz, seq, SSD_HEADS, SSD_HEADDIM)
    rep = SSD_HEADS // SSD_GROUPS
    bm = jnp.repeat(bm.reshape(bsz, seq, SSD_GROUPS, SSD_STATE), rep, axis=2)
    cm = jnp.repeat(cm.reshape(bsz, seq, SSD_GROUPS, SSD_STATE), rep, axis=2)
    dt = jax.nn.softplus(dt_raw.reshape(bsz, seq, N_DIR, SSD_HEADS) + p['ssd_dt_bias'].astype(f32))
    a_ssd = -jnp.exp(p['ssd_a_log'].astype(f32))
    h0s = init['ssd'].astype(f32)
    ys_f, hs_f = _ssd_scan(xs, dt[:, :, 0], a_ssd[0], bm, cm, h0s[:, 0])
    ys_b, hs_b = _ssd_scan(_rev(xs), _rev(dt[:, :, 1]), a_ssd[1], _rev(bm), _rev(cm), h0s[:, 1])
    y_ssd = ys_f + _rev(ys_b) + p['ssd_d'].astype(f32)[:, None] * xs
    y_ssd = y_ssd.reshape(bsz, seq, SSD_WIDTH) * jax.nn.silu(z)
    br_b = _rmsnorm(y_ssd, p['ssd_norm_g']) @ p['ssd_w_out']

    qkv = jax.nn.silu(_short_conv(qkv, p['dn_conv_w'].astype(f32), grid))
    q, k, v = jnp.split(qkv, (DN_QK, 2 * DN_QK), axis=-1)
    q = _l2norm(q.reshape(bsz, seq, DN_HEADS, DN_DK)) * (DN_DK ** -0.5)
    k = _l2norm(k.reshape(bsz, seq, DN_HEADS, DN_DK))
    v = v.reshape(bsz, seq, DN_HEADS, DN_DV)
    beta = jax.nn.sigmoid(beta_raw.reshape(bsz, seq, N_DIR, DN_HEADS))
    g_dn = -jnp.exp(p['dn_a_log'].astype(f32)) * jax.nn.softplus(a_raw.reshape(bsz, seq, N_DIR, DN_HEADS) + p['dn_dt_bias'].astype(f32))
    h0d = init['dn'].astype(f32)
    o_f, sd_f = _gated_delta(q, k, v, beta[:, :, 0], g_dn[:, :, 0], h0d[:, 0])
    o_b, sd_b = _gated_delta(_rev(q), _rev(k), _rev(v), _rev(beta[:, :, 1]), _rev(g_dn[:, :, 1]), h0d[:, 1])
    o = _rmsnorm(o_f + _rev(o_b), p['dn_norm_g']) * jax.nn.silu(dn_gate.reshape(bsz, seq, DN_HEADS, DN_DV))
    br_c = o.reshape(bsz, seq, DN_V) @ p['dn_w_out']

    gates = jax.nn.sigmoid(gate_raw.reshape(bsz, seq, N_BRANCH, D_MODEL))
    merged = gates[:, :, 0] * br_a + gates[:, :, 1] * br_b + gates[:, :, 2] * br_c
    out = (merged @ p['w_out']).astype(h.dtype)
    states = {'s5_re': jnp.stack([sfr, sbr], axis=1), 's5_im': jnp.stack([sfi, sbi], axis=1),
              'ssd': jnp.stack([hs_f, hs_b], axis=1), 'dn': jnp.stack([sd_f, sd_b], axis=1)}
    return out, states


def _swiglu(h, wi, wo):
    a, b = jnp.split(h @ wi, 2, axis=-1)
    return (jax.nn.silu(a) * b) @ wo


def _layer(x, cond, p, init, grid):
    mod = (jax.nn.silu(cond) @ p['ada_w'] + p['ada_b']).reshape(cond.shape[0], 1, N_ADA, D_MODEL)
    sh1, sc1, g1, sh2, sc2, g2, sh3, sc3, g3 = [mod[:, :, i] for i in range(N_ADA)]
    h = _rmsnorm(x, p['norm_g'][0]) * (1.0 + sc1) + sh1
    x = x + 0.5 * g1 * _swiglu(h, p['ffn_wi'][0], p['ffn_wo'][0])
    h = _rmsnorm(x, p['norm_g'][1]) * (1.0 + sc2) + sh2
    mix, states = _mixer_block(h, p, init, grid)
    x = x + g2 * mix
    h = _rmsnorm(x, p['norm_g'][2]) * (1.0 + sc3) + sh3
    x = x + 0.5 * g3 * _swiglu(h, p['ffn_wi'][1], p['ffn_wo'][1])
    return x, states


def setup_inputs(seed: int = 0) -> dict:
    key = jax.random.key(seed)
    ks = iter(jax.random.split(key, 48))

    def nrm(shape, scale):
        return jax.random.normal(next(ks), shape, jnp.float32) * scale

    def unif(shape, lo, hi):
        return jax.random.uniform(next(ks), shape, jnp.float32, lo, hi)

    def dt_bias(shape):
        dt = jnp.exp(unif(shape, float(np.log(1e-3)), float(np.log(1e-1))))
        return dt + jnp.log(-jnp.expm1(-dt))

    n_idx = jnp.arange(S5_STATE, dtype=jnp.float32)
    s5_shape = (DEPTH, N_DIR, S5_GROUPS, S5_STATE)
    return {
        'x_prompt': nrm((BATCH, SEQ, D_MODEL), 1.0),
        'x_sample': nrm((DEC_BATCH, DEC_SEQ, D_MODEL), 1.0),
        'state_s5_re': nrm((DEC_BATCH, DEPTH, N_DIR, S5_GROUPS, S5_STATE), 0.5),
        'state_s5_im': nrm((DEC_BATCH, DEPTH, N_DIR, S5_GROUPS, S5_STATE), 0.5),
        'state_ssd': nrm((DEC_BATCH, DEPTH, N_DIR, SSD_HEADS, SSD_HEADDIM, SSD_STATE), 0.1),
        'state_dn': nrm((DEC_BATCH, DEPTH, N_DIR, DN_HEADS, DN_DK, DN_DV), 0.1),
        'c': nrm((DEC_BATCH, D_MODEL), 1.0),
        'c_ctx': nrm((D_MODEL,), 1.0),
        'ada_w': nrm((DEPTH, D_MODEL, N_ADA * D_MODEL), 0.5 * D_MODEL ** -0.5),
        'ada_b': nrm((DEPTH, N_ADA * D_MODEL), 0.02),
        'norm_g': 1.0 + nrm((DEPTH, 3, D_MODEL), 0.05),
        'ffn_wi': nrm((DEPTH, 2, D_MODEL, 2 * D_FF), D_MODEL ** -0.5),
        'ffn_wo': nrm((DEPTH, 2, D_FF, D_MODEL), D_FF ** -0.5),
        'w_in': nrm((DEPTH, D_MODEL, IN_WIDTH), D_MODEL ** -0.5),
        's5_lam_re': -0.5 + nrm(s5_shape, 0.01),
        's5_lam_im': jnp.pi * n_idx + nrm(s5_shape, 0.01),
        's5_log_dt': unif((DEPTH, N_DIR, S5_GROUPS), float(np.log(1e-3)), float(np.log(1e-1))),
        's5_b_re': nrm((DEPTH, N_DIR, S5_GROUPS, S5_STATE, S5_GROUP), (2 * S5_GROUP) ** -0.5),
        's5_b_im': nrm((DEPTH, N_DIR, S5_GROUPS, S5_STATE, S5_GROUP), (2 * S5_GROUP) ** -0.5),
        's5_c_re': nrm((DEPTH, N_DIR, S5_GROUPS, S5_GROUP, S5_STATE), (2 * S5_STATE) ** -0.5),
        's5_c_im': nrm((DEPTH, N_DIR, S5_GROUPS, S5_GROUP, S5_STATE), (2 * S5_STATE) ** -0.5),
        's5_d': nrm((DEPTH, S5_WIDTH), 1.0),
        's5_glu': nrm((DEPTH, 2, S5_WIDTH, D_MODEL), S5_WIDTH ** -0.5),
        'ssd_conv_w': nrm((DEPTH, CONV_K, SSD_CONV_DIM), CONV_K ** -0.5),
        'ssd_conv_b': nrm((DEPTH, SSD_CONV_DIM), 0.02),
        'ssd_dt_bias': dt_bias((DEPTH, N_DIR, SSD_HEADS)),
        'ssd_a_log': jnp.log(unif((DEPTH, N_DIR, SSD_HEADS), 1.0, 16.0)),
        'ssd_d': 1.0 + nrm((DEPTH, SSD_HEADS), 0.05),
        'ssd_norm_g': 1.0 + nrm((DEPTH, SSD_WIDTH), 0.05),
        'ssd_w_out': nrm((DEPTH, SSD_WIDTH, D_MODEL), SSD_WIDTH ** -0.5),
        'dn_conv_w': nrm((DEPTH, CONV_K, DN_CONV_DIM), CONV_K ** -0.5),
        'dn_dt_bias': dt_bias((DEPTH, N_DIR, DN_HEADS)),
        'dn_a_log': jnp.log(unif((DEPTH, N_DIR, DN_HEADS), 1.0, 16.0)),
        'dn_norm_g': 1.0 + nrm((DEPTH, DN_DV), 0.05),
        'dn_w_out': nrm((DEPTH, DN_V, D_MODEL), DN_V ** -0.5),
        'w_out': nrm((DEPTH, D_MODEL, D_MODEL), D_MODEL ** -0.5),
        'final_norm_g': 1.0 + nrm((D_MODEL,), 0.05),
    }


def reference(x_prompt, x_sample, state_s5_re, state_s5_im, state_ssd, state_dn, c, c_ctx,
              ada_w, ada_b, norm_g, ffn_wi, ffn_wo, w_in,
              s5_lam_re, s5_lam_im, s5_log_dt, s5_b_re, s5_b_im, s5_c_re, s5_c_im, s5_d, s5_glu,
              ssd_conv_w, ssd_conv_b, ssd_dt_bias, ssd_a_log, ssd_d, ssd_norm_g, ssd_w_out,
              dn_conv_w, dn_dt_bias, dn_a_log, dn_norm_g, dn_w_out, w_out, final_norm_g):
    bsz = x_prompt.shape[0]
    f32 = jnp.float32
    zero_init = {'s5_re': jnp.zeros((bsz, N_DIR, S5_GROUPS, S5_STATE), f32),
                 's5_im': jnp.zeros((bsz, N_DIR, S5_GROUPS, S5_STATE), f32),
                 'ssd': jnp.zeros((bsz, N_DIR, SSD_HEADS, SSD_HEADDIM, SSD_STATE), f32),
                 'dn': jnp.zeros((bsz, N_DIR, DN_HEADS, DN_DK, DN_DV), f32)}
    h_ctx = x_prompt
    h_lat = x_sample
    ctx_states = []
    for l in range(DEPTH):
        p = {'ada_w': ada_w[l], 'ada_b': ada_b[l], 'norm_g': norm_g[l], 'ffn_wi': ffn_wi[l], 'ffn_wo': ffn_wo[l],
             'w_in': w_in[l], 's5_lam_re': s5_lam_re[l], 's5_lam_im': s5_lam_im[l], 's5_log_dt': s5_log_dt[l],
             's5_b_re': s5_b_re[l], 's5_b_im': s5_b_im[l], 's5_c_re': s5_c_re[l], 's5_c_im': s5_c_im[l],
             's5_d': s5_d[l], 's5_glu': s5_glu[l], 'ssd_conv_w': ssd_conv_w[l], 'ssd_conv_b': ssd_conv_b[l],
             'ssd_dt_bias': ssd_dt_bias[l], 'ssd_a_log': ssd_a_log[l], 'ssd_d': ssd_d[l],
             'ssd_norm_g': ssd_norm_g[l], 'ssd_w_out': ssd_w_out[l], 'dn_conv_w': dn_conv_w[l],
             'dn_dt_bias': dn_dt_bias[l], 'dn_a_log': dn_a_log[l], 'dn_norm_g': dn_norm_g[l],
             'dn_w_out': dn_w_out[l], 'w_out': w_out[l]}
        h_ctx, st = _layer(h_ctx, c_ctx[None, :], p, zero_init, grid=False)
        ctx_states.append(st)
        lat_init = {'s5_re': state_s5_re[:, l], 's5_im': state_s5_im[:, l],
                    'ssd': state_ssd[:, l], 'dn': state_dn[:, l]}
        h_lat, _ = _layer(h_lat, c, p, lat_init, grid=True)
    y_prompt = _rmsnorm(h_ctx, final_norm_g)
    y_sample = _rmsnorm(h_lat, final_norm_g)
    new_state_s5_re = jnp.stack([s['s5_re'] for s in ctx_states], axis=1)
    new_state_s5_im = jnp.stack([s['s5_im'] for s in ctx_states], axis=1)
    new_state_ssd = jnp.stack([s['ssd'] for s in ctx_states], axis=1)
    new_state_dn = jnp.stack([s['dn'] for s in ctx_states], axis=1)
    return (y_prompt, y_sample, new_state_s5_re, new_state_s5_im, new_state_ssd, new_state_dn)
```

```cpp
#include <hip/hip_runtime.h>
#include <hip/hip_bf16.h>
#include <hip/hip_cooperative_groups.h>
#include <cstdio>
namespace cg = cooperative_groups;

typedef unsigned short bfraw;
using bf16x8 = __attribute__((ext_vector_type(8))) short;
using f32x4 = __attribute__((ext_vector_type(4))) float;

#define NT 6144
#define DM 1024
#define DFF 2816
#define INW 6944
#define INWP 7040
#define EPSF 1e-6f
#define SMEM_BYTES 73728
#define LDSK 72
#define WT_SET ((size_t)27656192)

#define C_U 0
#define C_Z 512
#define C_XBC 1024
#define C_DT 1792
#define C_QKV 1808
#define C_BETA 3344
#define C_AR 3352
#define C_DNG 3360
#define C_GATE 3872

#define O_S5R 6291456
#define O_S5I 6553600
#define O_SSD 6815744
#define O_DN 11010048

struct P {
  const float *x_prompt, *x_sample, *st_s5r, *st_s5i, *st_ssd, *st_dn, *c, *c_ctx, *ada_w, *ada_b, *norm_g, *ffn_wi, *ffn_wo, *w_in,
      *s5_lam_re, *s5_lam_im, *s5_log_dt, *s5_b_re, *s5_b_im, *s5_c_re, *s5_c_im, *s5_d, *s5_glu, *ssd_conv_w, *ssd_conv_b,
      *ssd_dt_bias, *ssd_a_log, *ssd_d, *ssd_norm_g, *ssd_w_out, *dn_conv_w, *dn_dt_bias, *dn_a_log, *dn_norm_g, *dn_w_out, *w_out,
      *final_norm_g;
  float* out;
  float *x, *mod, *lbr, *lbi, *bbr, *bbi, *proj, *xbc, *qkv, *dtv, *dAv, *betav, *agv, *qkd, *s5y, *ssdy, *dny;
  bfraw *wt_wi, *wt_wo, *wt_win, *wt_glu, *wt_ssdo, *wt_dno, *wt_wout, *h, *act, *a_s5, *a_ssd, *a_dn;
  int* ctr;
  unsigned* bar;
  float *dn_u, *dn_ac, *ssd_ac;
  bfraw *dn_w, *dn_qa, *dn_kwt, *dn_qkd;
};

__device__ __forceinline__ bfraw f2bf(float f) {
  unsigned u = __float_as_uint(f);
  u += 0x7fffu + ((u >> 16) & 1u);
  return (bfraw)(u >> 16);
}
__device__ __forceinline__ unsigned pack2(float a, float b) { return (unsigned)f2bf(a) | ((unsigned)f2bf(b) << 16); }
__device__ __forceinline__ float siluf(float x) { return x / (1.f + __expf(-x)); }
__device__ __forceinline__ float sigmf(float x) { return 1.f / (1.f + __expf(-x)); }
__device__ __forceinline__ float softplusf(float x) { return fmaxf(x, 0.f) + log1pf(__expf(-fabsf(x))); }
__device__ __forceinline__ float gelu_tanh(float x) {
  float t = 0.7978845608028654f * (x + 0.044715f * x * x * x);
  return 0.5f * x * (1.f + tanhf(t));
}
__device__ __forceinline__ float wave_sum(float v) {
#pragma unroll
  for (int o = 32; o >= 1; o >>= 1) v += __shfl_xor(v, o, 64);
  return v;
}
template <int CTRL>
__device__ __forceinline__ float dppf(float v) {
  return __builtin_bit_cast(float, __builtin_amdgcn_update_dpp(0, __builtin_bit_cast(int, v), CTRL, 0xF, 0xF, false));
}
__device__ __forceinline__ float red16(float v) {
  v += dppf<0xB1>(v);
  v += dppf<0x4E>(v);
  v += dppf<0x141>(v);
  v += dppf<0x140>(v);
  return v;
}
__device__ __forceinline__ int otid() { int t = threadIdx.x; asm volatile("" : "+v"(t)); return t; }
__device__ __forceinline__ int obid() { int t = blockIdx.x; asm volatile("" : "+s"(t)); return t; }
#define XB_TMO      128
#define XB_XCNT(j)  (256  + 64 * (j))
#define XB_XSUB(j)  (1280 + 64 * (j))
#define XB_XGEN(j)  (2304 + 64 * (j))
#define XB_TOP      3328
#define XB_TOPGEN   3392
#define XCD_BAR_WORDS 3456
#define XB_SPIN_CAP (1u << 18)
#define LAS __attribute__((address_space(3)))

__device__ __forceinline__ unsigned xb_ld(unsigned* p)              { return __hip_atomic_load(p, __ATOMIC_RELAXED, __HIP_MEMORY_SCOPE_AGENT); }
__device__ __forceinline__ unsigned xb_add(unsigned* p, unsigned v) { return __hip_atomic_fetch_add(p, v, __ATOMIC_RELAXED, __HIP_MEMORY_SCOPE_AGENT); }
__device__ __forceinline__ unsigned xb_xcc_id() { return (unsigned)__builtin_amdgcn_s_getreg((3 << 11) | 20) & 0xFu; }
#define XB_SPIN(cond, bar) do { unsigned _sp = 0; while (cond) { __builtin_amdgcn_s_sleep(1); \
    if ((++_sp & 255u) == 0u) { if (xb_ld(&(bar)[XB_TMO])) break; if (_sp > XB_SPIN_CAP) { atomicAdd(&(bar)[XB_TMO], 1u); break; } } } } while (0)

struct XcdBarrier {
    unsigned* bar; unsigned x;
    volatile LAS unsigned* st;
};

__device__ __forceinline__ XcdBarrier xcd_barrier_post(unsigned* bar, volatile LAS unsigned* st) {
    XcdBarrier b; b.bar = bar; b.x = xb_xcc_id(); b.st = st;
    if (threadIdx.x == 0) (void)xb_add(&bar[XB_XCNT(b.x)], 1u);
    return b;
}
__device__ __forceinline__ void xcd_barrier_complete(unsigned* bar, unsigned x, unsigned& nloc, unsigned& nx) {
    const unsigned G = gridDim.x * gridDim.y * gridDim.z;
    unsigned sum, cnt, mine, sp = 0u;
    for (;;) {
        sum = 0u; cnt = 0u; mine = 0u;
#pragma unroll
        for (unsigned j = 0; j < 16; ++j) { const unsigned c = xb_ld(&bar[XB_XCNT(j)]); sum += c; cnt += (c > 0u) ? 1u : 0u; mine = (j == x) ? c : mine; }
        if (sum == G) break;
        __builtin_amdgcn_s_sleep(1);
        if ((++sp & 255u) == 0u) { if (xb_ld(&bar[XB_TMO])) break; if (sp > XB_SPIN_CAP) { atomicAdd(&bar[XB_TMO], 1u); break; } }
    }
    nloc = mine > 0u ? mine : 1u; nx = cnt > 0u ? cnt : 1u;
}

__device__ __forceinline__ void xcd_barrier(const XcdBarrier& b) {
    asm volatile("s_waitcnt vmcnt(0)" ::: "memory");
    __syncthreads();
    if (threadIdx.x == 0) {
        unsigned* bar = b.bar;
        __builtin_amdgcn_s_waitcnt(0);
        unsigned nloc = b.st[0], nx = b.st[1];
        if (nloc == 0u) { xcd_barrier_complete(bar, b.x, nloc, nx); b.st[0] = nloc; b.st[1] = nx; }
        const unsigned old = xb_add(&bar[XB_XSUB(b.x)], 1u);
        const unsigned gen = old / nloc;
        if (old + 1u == (gen + 1u) * nloc) {
            __builtin_amdgcn_fence(__ATOMIC_RELEASE, "agent");
            asm volatile("s_waitcnt vmcnt(0)" ::: "memory");
            const unsigned og = xb_add(&bar[XB_TOP], 1u);
            const unsigned tg = og / nx;
            if (og + 1u == (tg + 1u) * nx) xb_add(&bar[XB_TOPGEN], 1u);
            else XB_SPIN(xb_ld(&bar[XB_TOPGEN]) == tg, bar);
            __builtin_amdgcn_fence(__ATOMIC_ACQUIRE, "agent");
            xb_add(&bar[XB_XGEN(b.x)], 1u);
            asm volatile("s_waitcnt vmcnt(0)" ::: "memory");
        } else {
            XB_SPIN(xb_ld(&bar[XB_XGEN(b.x)]) == gen, bar);
            __builtin_amdgcn_fence(__ATOMIC_ACQUIRE, "agent");
            asm volatile("s_waitcnt vmcnt(0)" ::: "memory");
        }
    }
    __syncthreads();
}


__device__ __forceinline__ int cond_of(int row) { return row < 4096 ? 0 : 1 + ((row - 4096) >> 10); }

template <int NSUB, bool PAIRED, int MSUB = 4>
__device__ __forceinline__ void gemm_tile(const bfraw* __restrict__ A, int lda, const bfraw* __restrict__ Bt, int ldb, int K,
                                          int row0, int brow0, bfraw* sA, bfraw* sB, f32x4 (&acc)[MSUB][NSUB]) {
  constexpr int BN = NSUB * 32;
  const int tid = otid(), wid = tid >> 6, lane = tid & 63, wr = wid >> 1, wc = wid & 1, fr = lane & 15, fq = lane >> 4;
  uint4 ra0, ra1, ra2, ra3, rb0, rb1, rb2, rb3;
  const int cr = tid >> 3, cc = tid & 7;
  const bfraw* ga = A + (size_t)(row0 + cr) * lda + cc * 8;
  const bfraw* gb = Bt + (size_t)(brow0 + cr) * ldb + cc * 8;
  const int nk = K >> 6;
  rb2 = make_uint4(0, 0, 0, 0); rb3 = rb2; ra3 = rb2;
#define GLOAD(KO)                                               \
  ra0 = *(const uint4*)(ga + (size_t)(0) * lda + (KO));         \
  ra1 = *(const uint4*)(ga + (size_t)(32) * lda + (KO));        \
  ra2 = *(const uint4*)(ga + (size_t)(64) * lda + (KO));        \
  if (MSUB == 4) ra3 = *(const uint4*)(ga + (size_t)(96) * lda + (KO)); \
  rb0 = *(const uint4*)(gb + (size_t)(0) * ldb + (KO));         \
  rb1 = *(const uint4*)(gb + (size_t)(32) * ldb + (KO));        \
  if (NSUB == 4) {                                              \
    rb2 = *(const uint4*)(gb + (size_t)(64) * ldb + (KO));      \
    rb3 = *(const uint4*)(gb + (size_t)(96) * ldb + (KO));      \
  }
  GLOAD(0)
  int bcol[NSUB];
#pragma unroll
  for (int n = 0; n < NSUB; n++) bcol[n] = PAIRED ? ((n >> 1) * 64 + wc * 32 + (n & 1) * 16) : (wc * (NSUB * 16) + n * 16);
  for (int kt = 0; kt < nk; kt++) {
    const int buf = kt & 1;
    bfraw* a_s = sA + buf * (128 * LDSK);
    bfraw* b_s = sB + buf * (BN * LDSK);
    *(uint4*)(a_s + (cr + 0) * LDSK + cc * 8) = ra0;
    *(uint4*)(a_s + (cr + 32) * LDSK + cc * 8) = ra1;
    *(uint4*)(a_s + (cr + 64) * LDSK + cc * 8) = ra2;
    if (MSUB == 4) *(uint4*)(a_s + (cr + 96) * LDSK + cc * 8) = ra3;
    *(uint4*)(b_s + (cr + 0) * LDSK + cc * 8) = rb0;
    *(uint4*)(b_s + (cr + 32) * LDSK + cc * 8) = rb1;
    if (NSUB == 4) {
      *(uint4*)(b_s + (cr + 64) * LDSK + cc * 8) = rb2;
      *(uint4*)(b_s + (cr + 96) * LDSK + cc * 8) = rb3;
    }
    __syncthreads();
    if (kt + 1 < nk) { GLOAD((kt + 1) * 64) }
    __builtin_amdgcn_sched_barrier(0);
#pragma unroll
    for (int ks = 0; ks < 2; ks++) {
      bf16x8 af[MSUB], bfv[NSUB];
#pragma unroll
      for (int m = 0; m < MSUB; m++) af[m] = *(const bf16x8*)(a_s + (wr * (MSUB * 16) + m * 16 + fr) * LDSK + ks * 32 + fq * 8);
#pragma unroll
      for (int n = 0; n < NSUB; n++) bfv[n] = *(const bf16x8*)(b_s + (bcol[n] + fr) * LDSK + ks * 32 + fq * 8);
      __builtin_amdgcn_s_setprio(1);
#pragma unroll
      for (int m = 0; m < MSUB; m++)
#pragma unroll
        for (int n = 0; n < NSUB; n++) acc[m][n] = __builtin_amdgcn_mfma_f32_16x16x32_bf16(bfv[n], af[m], acc[m][n], 0, 0, 0);
      __builtin_amdgcn_s_setprio(0);
    }
  }
  __syncthreads();
#undef GLOAD
}

#define GEMM_IDS                                                                                              \
  const int tid = otid(), wid = tid >> 6, lane = tid & 63, wr = wid >> 1, wc = wid & 1, fr = lane & 15, \
            fq = lane >> 4;                                                                                   \
  bfraw* sA = (bfraw*)smem;                                                                                   \
  bfraw* sB = sA + 2 * 128 * LDSK;                                                                            \
  (void)tid; (void)wid; (void)lane; (void)wr; (void)wc; (void)fr; (void)fq;

__device__ void convert_one(const P& p, int l, int t, char* smem);
__device__ void phase_swiglu(const P& p, const bfraw* Wt, char* smem) {
  GEMM_IDS
  for (int tile = obid(); tile < 48 * 44; tile += gridDim.x) {
    const int mt = tile % 48, nt = tile / 48;
    f32x4 acc[4][4];
#pragma unroll
    for (int m = 0; m < 4; m++)
#pragma unroll
      for (int n = 0; n < 4; n++) acc[m][n] = f32x4{0.f, 0.f, 0.f, 0.f};
    gemm_tile<4, true>(p.h, DM, Wt, DM, DM, mt * 128, nt * 128, sA, sB, acc);
#pragma unroll
    for (int m = 0; m < 4; m++)
#pragma unroll
      for (int n = 0; n < 2; n++) {
        const int row = mt * 128 + wr * 64 + m * 16 + fr;
        const int col = nt * 64 + wc * 32 + n * 16 + fq * 4;
        const f32x4 a = acc[m][n], b = acc[m][n + 2];
        *(uint2*)(p.act + (size_t)row * DFF + col) =
            make_uint2(pack2(siluf(a[0]) * b[0], siluf(a[1]) * b[1]), pack2(siluf(a[2]) * b[2], siluf(a[3]) * b[3]));
      }
  }
}

__device__ void phase_resid(const P& p, const bfraw* A, const bfraw* Wt, int K, const float* gate  ,
                            float scale, int cl  , int cbeg, int cend, char* smem) {
  GEMM_IDS
  if (cl >= 0) {
    if (gridDim.x > 384) {
      if (obid() >= 384) {
        for (int t = cbeg + (obid() - 384); t < cend; t += (gridDim.x - 384)) convert_one(p, cl, t, smem);
        return;
      }
    } else {
      for (int t = cbeg + obid(); t < cend; t += gridDim.x) convert_one(p, cl, t, smem);
    }
  }
  for (int tile = obid(); tile < 48 * 8; tile += gridDim.x) {
    const int mt = tile % 48, nt = tile / 48;
    f32x4 acc[4][4];
#pragma unroll
    for (int m = 0; m < 4; m++)
#pragma unroll
      for (int n = 0; n < 4; n++) acc[m][n] = f32x4{0.f, 0.f, 0.f, 0.f};
    gemm_tile<4, false>(A, K, Wt, K, K, mt * 128, nt * 128, sA, sB, acc);
#pragma unroll
    for (int m = 0; m < 4; m++)
#pragma unroll
      for (int n = 0; n < 4; n++) {
        const int row = mt * 128 + wr * 64 + m * 16 + fr;
        const int col = nt * 128 + wc * 64 + n * 16 + fq * 4;
        const float4 g = *(const float4*)(gate + cond_of(row) * 9216 + col);
        float4* xp = (float4*)(p.x + (size_t)row * DM + col);
        float4 xv = *xp;
        xv.x += scale * g.x * acc[m][n][0];
        xv.y += scale * g.y * acc[m][n][1];
        xv.z += scale * g.z * acc[m][n][2];
        xv.w += scale * g.w * acc[m][n][3];
        *xp = xv;
      }
  }
}

__device__ void phase_proj(const P& p, size_t wo, char* smem) {
  GEMM_IDS
  for (int tile = obid(); tile < 48 * 55; tile += gridDim.x) {
    const int mt = tile % 48, nt = tile / 48;
    f32x4 acc[4][4];
#pragma unroll
    for (int m = 0; m < 4; m++)
#pragma unroll
      for (int n = 0; n < 4; n++) acc[m][n] = f32x4{0.f, 0.f, 0.f, 0.f};
    gemm_tile<4, false>(p.h, DM, p.wt_win + wo, DM, DM, mt * 128, nt * 128, sA, sB, acc);
#pragma unroll
    for (int m = 0; m < 4; m++)
#pragma unroll
      for (int n = 0; n < 4; n++) {
        const int row = mt * 128 + wr * 64 + m * 16 + fr;
        const int col = nt * 128 + wc * 64 + n * 16 + fq * 4;
        *(float4*)(p.proj + (size_t)row * INWP + col) = make_float4(acc[m][n][0], acc[m][n][1], acc[m][n][2], acc[m][n][3]);
      }
  }
}

__device__ __forceinline__ float bflo(unsigned u) { return __uint_as_float(u << 16); }
__device__ __forceinline__ float bfhi(unsigned u) { return __uint_as_float(u & 0xffff0000u); }
template <int STEP>
__device__ __forceinline__ void merge_step(const P& p, const bfraw* A, const bfraw* Wt, int mt, int nt, char* smem) {
  GEMM_IDS
  f32x4 acc[4][4];
#pragma unroll
  for (int m = 0; m < 4; m++)
#pragma unroll
    for (int n = 0; n < 4; n++) acc[m][n] = f32x4{0.f, 0.f, 0.f, 0.f};
  gemm_tile<4, false>(A, 512, Wt, 512, 512, mt * 128, nt * 128, sA, sB, acc);
#pragma unroll
  for (int m = 0; m < 4; m++)
#pragma unroll
    for (int n = 0; n < 4; n++) {
      const int row = mt * 128 + wr * 64 + m * 16 + fr;
      const int col = nt * 128 + wc * 64 + n * 16 + fq * 4;
      uint2* hp = (uint2*)(p.h + (size_t)row * DM + col);
      float r0, r1, r2, r3;
      if (STEP == 0) {
        r0 = sigmf(acc[m][n][0]); r1 = sigmf(acc[m][n][1]); r2 = sigmf(acc[m][n][2]); r3 = sigmf(acc[m][n][3]);
      } else {
        const float4 g = *(const float4*)(p.proj + (size_t)row * INWP + C_GATE + (STEP - 1) * 1024 + col);
        const uint2 hv = *hp;
        const float t0 = sigmf(g.x) * acc[m][n][0], t1 = sigmf(g.y) * acc[m][n][1], t2 = sigmf(g.z) * acc[m][n][2], t3 = sigmf(g.w) * acc[m][n][3];
        if (STEP == 1) { r0 = bflo(hv.x) * t0; r1 = bfhi(hv.x) * t1; r2 = bflo(hv.y) * t2; r3 = bfhi(hv.y) * t3; }
        else { r0 = bflo(hv.x) + t0; r1 = bfhi(hv.x) + t1; r2 = bflo(hv.y) + t2; r3 = bfhi(hv.y) + t3; }
      }
      *hp = make_uint2(pack2(r0, r1), pack2(r2, r3));
    }
}
__device__ void phase_merge(const P& p, size_t wo, char* smem) {
  for (int tile = obid(); tile < 48 * 8; tile += gridDim.x) {
    const int mt = tile % 48, nt = tile / 48;
    merge_step<0>(p, p.a_s5, p.wt_glu + wo + 1024 * 512, mt, nt, smem);
    merge_step<1>(p, p.a_s5, p.wt_glu + wo, mt, nt, smem);
    merge_step<2>(p, p.a_ssd, p.wt_ssdo + wo, mt, nt, smem);
    merge_step<3>(p, p.a_dn, p.wt_dno + wo, mt, nt, smem);
  }
}

__device__ void conv_tile(const float* __restrict__ src, int K, int Nsrc, bfraw* __restrict__ dst, int kt, int nt, int scol0,
                          float* tile  ) {
  const int tid = otid();
  {
    const int r = tid >> 4, c4 = tid & 15;
#pragma unroll
    for (int rr = 0; rr < 4; rr++) {
      const int k = rr * 16 + r;
      float4 v = make_float4(0.f, 0.f, 0.f, 0.f);
      if (scol0 + c4 * 4 + 3 < Nsrc) v = *(const float4*)(src + (size_t)(kt * 64 + k) * Nsrc + scol0 + c4 * 4);
      tile[k * 65 + c4 * 4 + 0] = v.x;
      tile[k * 65 + c4 * 4 + 1] = v.y;
      tile[k * 65 + c4 * 4 + 2] = v.z;
      tile[k * 65 + c4 * 4 + 3] = v.w;
    }
  }
  __syncthreads();
  {
    const int n = tid >> 2, kq = tid & 3;
    unsigned w[8];
#pragma unroll
    for (int e = 0; e < 8; e++) {
      const float a = tile[(kq * 16 + 2 * e) * 65 + n], b = tile[(kq * 16 + 2 * e + 1) * 65 + n];
      w[e] = (unsigned)f2bf(a) | ((unsigned)f2bf(b) << 16);
    }
    bfraw* d = dst + (size_t)(nt * 64 + n) * K + kt * 64 + kq * 16;
    *(uint4*)(d) = make_uint4(w[0], w[1], w[2], w[3]);
    *(uint4*)(d + 8) = make_uint4(w[4], w[5], w[6], w[7]);
  }
  __syncthreads();
}

__device__ void conv_tile4(const float* __restrict__ src, int K, int Nsrc, bfraw* __restrict__ dst, int kt, int nt0, int ntiles,
                           bool paired, float* tile  ) {
  const int tid = otid();
  const int r = tid >> 4, c4 = tid & 15;
  float4 v[4][4];
#pragma unroll
  for (int q = 0; q < 4; q++) {
    const int nt = nt0 + q;
    const int scol0 = paired ? ((nt & 1) * 2816 + (nt >> 1) * 64) : nt * 64;
    const bool ok = (nt < ntiles) && (scol0 + c4 * 4 + 3 < Nsrc);
#pragma unroll
    for (int rr = 0; rr < 4; rr++) {
      v[q][rr] = make_float4(0.f, 0.f, 0.f, 0.f);
      if (ok) v[q][rr] = *(const float4*)(src + (size_t)(kt * 64 + rr * 16 + r) * Nsrc + scol0 + c4 * 4);
    }
  }
#pragma unroll
  for (int q = 0; q < 4; q++) {
    const int nt = nt0 + q;
    if (nt < ntiles) {
#pragma unroll
      for (int rr = 0; rr < 4; rr++) {
        const int k = rr * 16 + r;
        tile[k * 65 + c4 * 4 + 0] = v[q][rr].x;
        tile[k * 65 + c4 * 4 + 1] = v[q][rr].y;
        tile[k * 65 + c4 * 4 + 2] = v[q][rr].z;
        tile[k * 65 + c4 * 4 + 3] = v[q][rr].w;
      }
      __syncthreads();
      {
        const int n = tid >> 2, kq = tid & 3;
        unsigned w[8];
#pragma unroll
        for (int e = 0; e < 8; e++) {
          const float x0 = tile[(kq * 16 + 2 * e) * 65 + n], x1 = tile[(kq * 16 + 2 * e + 1) * 65 + n];
          w[e] = (unsigned)f2bf(x0) | ((unsigned)f2bf(x1) << 16);
        }
        bfraw* d = dst + (size_t)(nt * 64 + n) * K + kt * 64 + kq * 16;
        *(uint4*)(d) = make_uint4(w[0], w[1], w[2], w[3]);
        *(uint4*)(d + 8) = make_uint4(w[4], w[5], w[6], w[7]);
      }
      __syncthreads();
    }
  }
}

#define NCONV 1696
__device__ void convert_one(const P& p, int l, int t, char* smem) {
  float* tile = (float*)smem;
  const size_t wo = (size_t)(l & 1) * WT_SET;
  int u = t;
  if (u < 704) {
    const int s = u / 352; u -= s * 352;
    const int kt = u & 15, nq = u >> 4;
    conv_tile4(p.ffn_wi + (size_t)(l * 2 + s) * 1024 * 5632, 1024, 5632, p.wt_wi + wo + (size_t)s * 5632 * 1024, kt, nq * 4, 88, true, tile);
  } else if (u < 1056) {
    u -= 704;
    const int s = u / 176; u -= s * 176;
    const int kt = u % 44, nq = u / 44;
    conv_tile4(p.ffn_wo + (size_t)(l * 2 + s) * 2816 * 1024, 2816, 1024, p.wt_wo + wo + (size_t)s * 1024 * 2816, kt, nq * 4, 16, false, tile);
  } else if (u < 1504) {
    u -= 1056;
    const int kt = u & 15, nq = u >> 4;
    conv_tile4(p.w_in + (size_t)l * 1024 * 6944, 1024, 6944, p.wt_win + wo, kt, nq * 4, 110, false, tile);
  } else if (u < 1568) {
    u -= 1504;
    const int s = u >> 5; u &= 31;
    const int kt = u & 7, nq = u >> 3;
    conv_tile4(p.s5_glu + (size_t)(l * 2 + s) * 512 * 1024, 512, 1024, p.wt_glu + wo + (size_t)s * 1024 * 512, kt, nq * 4, 16, false, tile);
  } else if (u < 1600) {
    u -= 1568;
    const int kt = u & 7, nq = u >> 3;
    conv_tile4(p.ssd_w_out + (size_t)l * 512 * 1024, 512, 1024, p.wt_ssdo + wo, kt, nq * 4, 16, false, tile);
  } else if (u < 1632) {
    u -= 1600;
    const int kt = u & 7, nq = u >> 3;
    conv_tile4(p.dn_w_out + (size_t)l * 512 * 1024, 512, 1024, p.wt_dno + wo, kt, nq * 4, 16, false, tile);
  } else {
    u -= 1632;
    const int kt = u & 15, nq = u >> 4;
    conv_tile4(p.w_out + (size_t)l * 1024 * 1024, 1024, 1024, p.wt_wout + wo, kt, nq * 4, 16, false, tile);
  }
}

__device__ void phase_init(const P& p, char* smem) {
  const int tid = otid(), wid = tid >> 6, lane = tid & 63;
  const int gtid = obid() * 256 + tid, gsz = gridDim.x * 256;
  if (gtid < 8) p.ctr[gtid] = 0;
  for (int i = gtid; i < NT * DM / 4; i += gsz) {
    float4 v = (i < 4096 * 256) ? ((const float4*)p.x_prompt)[i] : ((const float4*)p.x_sample)[i - 4096 * 256];
    ((float4*)p.x)[i] = v;
  }
  for (int i = gtid; i < 4 * 2 * 32 * 64; i += gsz) {
    const int ldg = i >> 6;
    const float dt = __expf(p.s5_log_dt[ldg]);
    const float lr = p.s5_lam_re[i], li = p.s5_lam_im[i];
    const float mag = expf(lr * dt);
    const float br = mag * cosf(li * dt), bi = mag * sinf(li * dt);
    const float den = lr * lr + li * li;
    const float cr = ((br - 1.f) * lr + bi * li) / den;
    const float ci = (bi * lr - (br - 1.f) * li) / den;
    p.lbr[i] = br;
    p.lbi[i] = bi;
#pragma unroll
    for (int k = 0; k < 16; k++) {
      const float b_re = p.s5_b_re[(size_t)i * 16 + k], b_im = p.s5_b_im[(size_t)i * 16 + k];
      p.bbr[(size_t)i * 16 + k] = cr * b_re - ci * b_im;
      p.bbi[(size_t)i * 16 + k] = cr * b_im + ci * b_re;
    }
  }
}

__device__ void ada_one(const P& p, int l, int cb, char* smem) {
  const int tid = otid(), lane = tid & 63;
  float* sc = (float*)smem;
  float* red = sc + 3 * 1024;
  for (int i = tid; i < 3 * 1024; i += 256) {
    const int c = i >> 10, k = i & 1023;
    const float v = (c == 0) ? p.c_ctx[k] : p.c[(c - 1) * 1024 + k];
    sc[i] = siluf(v);
  }
  __syncthreads();
  {
    const int kg = tid >> 4, c4 = tid & 15;
    const float* w = p.ada_w + (size_t)l * 1024 * 9216 + cb * 64 + c4 * 4 + (size_t)(kg * 64) * 9216;
    float4 a0 = make_float4(0.f, 0.f, 0.f, 0.f), a1 = a0, a2 = a0;
#pragma unroll 16
    for (int kk = 0; kk < 64; kk++) {
      const float4 wv = *(const float4*)(w + (size_t)kk * 9216);
      const int k = kg * 64 + kk;
      const float s0 = sc[k], s1 = sc[1024 + k], s2 = sc[2048 + k];
      a0.x += s0 * wv.x; a0.y += s0 * wv.y; a0.z += s0 * wv.z; a0.w += s0 * wv.w;
      a1.x += s1 * wv.x; a1.y += s1 * wv.y; a1.z += s1 * wv.z; a1.w += s1 * wv.w;
      a2.x += s2 * wv.x; a2.y += s2 * wv.y; a2.z += s2 * wv.z; a2.w += s2 * wv.w;
    }
    *(float4*)(red + (kg * 3 + 0) * 64 + c4 * 4) = a0;
    *(float4*)(red + (kg * 3 + 1) * 64 + c4 * 4) = a1;
    *(float4*)(red + (kg * 3 + 2) * 64 + c4 * 4) = a2;
    __syncthreads();
    if (tid < 192) {
      const int c = tid >> 6;
      float sacc = 0.f;
#pragma unroll
      for (int g = 0; g < 16; g++) sacc += red[(g * 3 + c) * 64 + lane];
      p.mod[(size_t)(l * 3 + c) * 9216 + cb * 64 + lane] = sacc + p.ada_b[(size_t)l * 9216 + cb * 64 + lane];
    }
    __syncthreads();
  }
}

__device__ void phase_normmod(const P& p, int l, int sub) {
  const int wid = otid() >> 6, lane = otid() & 63;
  const float* g = p.norm_g + (size_t)(l * 3 + sub) * 1024;
  for (int tok = obid() * 4 + wid; tok < NT; tok += gridDim.x * 4) {
    const float* xr = p.x + (size_t)tok * DM;
    float4 v[4];
    float ss = 0.f;
#pragma unroll
    for (int i = 0; i < 4; i++) {
      v[i] = *(const float4*)(xr + lane * 4 + i * 256);
      ss += v[i].x * v[i].x + v[i].y * v[i].y + v[i].z * v[i].z + v[i].w * v[i].w;
    }
    ss = wave_sum(ss);
    const float r = rsqrtf(ss * (1.f / 1024.f) + EPSF);
    const float* md = p.mod + (size_t)(l * 3 + cond_of(tok)) * 9216 + sub * 3 * 1024;
#pragma unroll
    for (int i = 0; i < 4; i++) {
      const int c = lane * 4 + i * 256;
      const float4 gg = *(const float4*)(g + c);
      const float4 sh = *(const float4*)(md + c);
      const float4 scv = *(const float4*)(md + 1024 + c);
      const float o0 = v[i].x * r * gg.x * (1.f + scv.x) + sh.x;
      const float o1 = v[i].y * r * gg.y * (1.f + scv.y) + sh.y;
      const float o2 = v[i].z * r * gg.z * (1.f + scv.z) + sh.z;
      const float o3 = v[i].w * r * gg.w * (1.f + scv.w) + sh.w;
      uint2 o;
      o.x = (unsigned)f2bf(o0) | ((unsigned)f2bf(o1) << 16);
      o.y = (unsigned)f2bf(o2) | ((unsigned)f2bf(o3) << 16);
      *(uint2*)(p.h + (size_t)tok * DM + c) = o;
    }
  }
}

__device__ void phase_final(const P& p) {
  const int wid = otid() >> 6, lane = otid() & 63;
  for (int tok = obid() * 4 + wid; tok < NT; tok += gridDim.x * 4) {
    const float* xr = p.x + (size_t)tok * DM;
    float4 v[4];
    float ss = 0.f;
#pragma unroll
    for (int i = 0; i < 4; i++) {
      v[i] = *(const float4*)(xr + lane * 4 + i * 256);
      ss += v[i].x * v[i].x + v[i].y * v[i].y + v[i].z * v[i].z + v[i].w * v[i].w;
    }
    ss = wave_sum(ss);
    const float r = rsqrtf(ss * (1.f / 1024.f) + EPSF);
#pragma unroll
    for (int i = 0; i < 4; i++) {
      const int c = lane * 4 + i * 256;
      const float4 gg = *(const float4*)(p.final_norm_g + c);
      float4 o = make_float4(v[i].x * r * gg.x, v[i].y * r * gg.y, v[i].z * r * gg.z, v[i].w * r * gg.w);
      *(float4*)(p.out + (size_t)tok * DM + c) = o;
    }
  }
}

__device__ __forceinline__ float half_sum(float v) {
#pragma unroll
  for (int o = 16; o >= 1; o >>= 1) v += __shfl_xor(v, o, 64);
  return v;
}
__device__ __forceinline__ float4 conv3(const float4 w0, const float4 w1, const float4 w2, const float4 xm, const float4 x0,
                                        const float4 xp, float fp, float fn) {
  float4 r;
  r.x = w0.x * fp * xm.x + w1.x * x0.x + w2.x * fn * xp.x;
  r.y = w0.y * fp * xm.y + w1.y * x0.y + w2.y * fn * xp.y;
  r.z = w0.z * fp * xm.z + w1.z * x0.z + w2.z * fn * xp.z;
  r.w = w0.w * fp * xm.w + w1.w * x0.w + w2.w * fn * xp.w;
  return r;
}
__device__ void phase_prep(const P& p, int l) {
  const int wid = otid() >> 6, lane = otid() & 63;
  const float* cw = p.ssd_conv_w + (size_t)l * 3 * 768;
  const float* cb = p.ssd_conv_b + (size_t)l * 768;
  const float* dw = p.dn_conv_w + (size_t)l * 3 * 1536;
  for (int tok = obid() * 4 + wid; tok < NT; tok += gridDim.x * 4) {
    bool hp, hn;
    if (tok < 4096) { const int t = tok & 255; hp = t > 0; hn = t < 255; }
    else { const int w = (tok - 4096) & 63; hp = w > 0; hn = w < 63; }
    const float* pr = p.proj + (size_t)tok * INWP;
    const float* pm = hp ? pr - INWP : pr;
    const float* pn = hn ? pr + INWP : pr;
    const float fp = hp ? 1.f : 0.f, fn = hn ? 1.f : 0.f;
#pragma unroll
    for (int i = 0; i < 3; i++) {
      const int c = lane * 4 + 256 * i;
      float4 v = conv3(*(const float4*)(cw + c), *(const float4*)(cw + 768 + c), *(const float4*)(cw + 1536 + c),
                       *(const float4*)(pm + C_XBC + c), *(const float4*)(pr + C_XBC + c), *(const float4*)(pn + C_XBC + c), fp, fn);
      const float4 bb = *(const float4*)(cb + c);
      v.x = siluf(v.x + bb.x); v.y = siluf(v.y + bb.y); v.z = siluf(v.z + bb.z); v.w = siluf(v.w + bb.w);
      *(float4*)(p.xbc + (size_t)tok * 768 + c) = v;
    }
#pragma unroll
    for (int hpair = 0; hpair < 2; hpair++) {
      const int hh = hpair * 2 + (lane >> 5);
      const int cq = hh * 128 + (lane & 31) * 4, ck = 512 + cq, cv = 1024 + cq;
      float4 q = conv3(*(const float4*)(dw + cq), *(const float4*)(dw + 1536 + cq), *(const float4*)(dw + 3072 + cq),
                       *(const float4*)(pm + C_QKV + cq), *(const float4*)(pr + C_QKV + cq), *(const float4*)(pn + C_QKV + cq), fp, fn);
      float4 k = conv3(*(const float4*)(dw + ck), *(const float4*)(dw + 1536 + ck), *(const float4*)(dw + 3072 + ck),
                       *(const float4*)(pm + C_QKV + ck), *(const float4*)(pr + C_QKV + ck), *(const float4*)(pn + C_QKV + ck), fp, fn);
      float4 v = conv3(*(const float4*)(dw + cv), *(const float4*)(dw + 1536 + cv), *(const float4*)(dw + 3072 + cv),
                       *(const float4*)(pm + C_QKV + cv), *(const float4*)(pr + C_QKV + cv), *(const float4*)(pn + C_QKV + cv), fp, fn);
      q.x = siluf(q.x); q.y = siluf(q.y); q.z = siluf(q.z); q.w = siluf(q.w);
      k.x = siluf(k.x); k.y = siluf(k.y); k.z = siluf(k.z); k.w = siluf(k.w);
      v.x = siluf(v.x); v.y = siluf(v.y); v.z = siluf(v.z); v.w = siluf(v.w);
      const float sq = half_sum(q.x * q.x + q.y * q.y + q.z * q.z + q.w * q.w);
      const float sk = half_sum(k.x * k.x + k.y * k.y + k.z * k.z + k.w * k.w);
      const float rq = rsqrtf(sq + EPSF) * 0.08838834764831845f;
      const float rk = rsqrtf(sk + EPSF);
      *(float4*)(p.qkv + (size_t)tok * 1536 + cq) = make_float4(q.x * rq, q.y * rq, q.z * rq, q.w * rq);
      *(float4*)(p.qkv + (size_t)tok * 1536 + ck) = make_float4(k.x * rk, k.y * rk, k.z * rk, k.w * rk);
      *(float4*)(p.qkv + (size_t)tok * 1536 + cv) = v;
    }
    if (lane < 16) {
      const float dt = softplusf(pr[C_DT + lane] + p.ssd_dt_bias[l * 16 + lane]);
      const float a = -__expf(p.ssd_a_log[l * 16 + lane]);
      p.dtv[tok * 16 + lane] = dt;
      p.dAv[tok * 16 + lane] = dt * a;
    }
    if (lane < 8) {
      p.betav[tok * 8 + lane] = sigmf(pr[C_BETA + lane]);
      const float g = -__expf(p.dn_a_log[l * 8 + lane]) * softplusf(pr[C_AR + lane] + p.dn_dt_bias[l * 8 + lane]);
      p.agv[tok * 8 + lane] = g;
    }
  }
}

__device__ __forceinline__ int tok_of(int base, int L, int dir, int tpos) { return base + (dir ? (L - 1 - tpos) : tpos); }


__device__ void s5_task(const P& p, int l, int seq, int dir, int g, char* smem) {
  const int tid = otid(), wid = tid >> 6, lane = tid & 63, fr = lane & 15, fq = lane >> 4;
  const bool ctx = seq < 16;
  const int L = ctx ? 256 : 1024, base = ctx ? seq * 256 : 4096 + (seq - 16) * 1024, Lq = L >> 2;
  const int ldg = (l * 2 + dir) * 32 + g;
  const int pidx = ldg * 64 + lane;
  const float lr = p.lbr[pidx], li = p.lbi[pidx];
  bf16x8 bbf[8];
#pragma unroll
  for (int nt = 0; nt < 8; nt++) {
    const float* src = ((nt < 4) ? p.bbr : p.bbi) + ((size_t)ldg * 64 + (nt & 3) * 16 + fr) * 16;
#pragma unroll
    for (int e = 0; e < 8; e++) {
      const int k = fq * 8 + e;
      const float v = src[k & 15];
      bbf[nt][e] = (short)f2bf((k < 16) ? v : 0.f);
    }
  }
  bf16x8 cf[4];
#pragma unroll
  for (int ks = 0; ks < 4; ks++)
#pragma unroll
    for (int e = 0; e < 8; e++) {
      const int k = ks * 32 + fq * 8 + e;
      const float v = (k < 64) ? p.s5_c_re[((size_t)ldg * 16 + fr) * 64 + k] : -p.s5_c_im[((size_t)ldg * 16 + fr) * 64 + (k - 64)];
      cf[ks][e] = (short)f2bf(v);
    }
  float pr_ = lr, pi_ = li;
  const int nsq = ctx ? 6 : 8;
  for (int i = 0; i < nsq; i++) {
    const float nr = pr_ * pr_ - pi_ * pi_, ni = 2.f * pr_ * pi_;
    pr_ = nr; pi_ = ni;
  }
  bfraw* U16b = (bfraw*)smem + wid * 256;
  float* BUT = (float*)(smem + 2048) + wid * (128 * 20);
  bfraw* H16 = (bfraw*)(smem + 2048 + 4 * 128 * 20 * 4) + wid * (16 * 136);
  float* E = (float*)(smem + 2048 + 4 * 128 * 20 * 4 + 4 * 16 * 136 * 2);
  float* ybuf = p.s5y + (size_t)dir * NT * 512;
  const int nsc = Lq >> 4;
  float h0r = 0.f, h0i = 0.f;
  if (!ctx) {
    const size_t si = ((((size_t)(seq - 16) * 4 + l) * 2 + dir) * 32 + g) * 64 + lane;
    h0r = p.st_s5r[si];
    h0i = p.st_s5i[si];
  }
  float hr = 0.f, hi = 0.f;
  for (int pass = 0; pass < 2; pass++) {
    const int utt = lane >> 2, uq = lane & 3;
    float4 up = *(const float4*)(p.proj + (size_t)tok_of(base, L, dir, wid * Lq + utt) * INWP + C_U + g * 16 + uq * 4);
    for (int sc = 0; sc < nsc; sc++) {
      *(uint2*)(U16b + utt * 16 + uq * 4) = make_uint2(pack2(up.x, up.y), pack2(up.z, up.w));
      __syncthreads();
      if (sc + 1 < nsc) up = *(const float4*)(p.proj + (size_t)tok_of(base, L, dir, wid * Lq + (sc + 1) * 16 + utt) * INWP + C_U + g * 16 + uq * 4);
      {
        bf16x8 a = bf16x8{0, 0, 0, 0, 0, 0, 0, 0};
        if (fq < 2) a = *(const bf16x8*)(U16b + fr * 16 + fq * 8);
#pragma unroll
        for (int nt = 0; nt < 8; nt++) {
          f32x4 acc = f32x4{0.f, 0.f, 0.f, 0.f};
          acc = __builtin_amdgcn_mfma_f32_16x16x32_bf16(a, bbf[nt], acc, 0, 0, 0);
          *(float4*)(BUT + (nt * 16 + fr) * 20 + fq * 4) = make_float4(acc[0], acc[1], acc[2], acc[3]);
        }
      }
      __syncthreads();
      float br[16], bi[16];
#pragma unroll
      for (int c = 0; c < 4; c++) {
        const float4 t0 = *(const float4*)(BUT + lane * 20 + c * 4);
        const float4 t1 = *(const float4*)(BUT + (64 + lane) * 20 + c * 4);
        br[c * 4 + 0] = t0.x; br[c * 4 + 1] = t0.y; br[c * 4 + 2] = t0.z; br[c * 4 + 3] = t0.w;
        bi[c * 4 + 0] = t1.x; bi[c * 4 + 1] = t1.y; bi[c * 4 + 2] = t1.z; bi[c * 4 + 3] = t1.w;
      }
#pragma unroll
      for (int s = 0; s < 16; s++) {
        const float nr = lr * hr - li * hi + br[s];
        const float ni = lr * hi + li * hr + bi[s];
        hr = nr; hi = ni;
        if (pass == 1) {
          H16[s * 136 + lane] = f2bf(hr);
          H16[s * 136 + 64 + lane] = f2bf(hi);
        }
      }
      if (pass == 1) {
        __syncthreads();
        f32x4 acc = f32x4{0.f, 0.f, 0.f, 0.f};
#pragma unroll
        for (int ks = 0; ks < 4; ks++) {
          const bf16x8 a = *(const bf16x8*)(H16 + fr * 136 + ks * 32 + fq * 8);
          acc = __builtin_amdgcn_mfma_f32_16x16x32_bf16(cf[ks], a, acc, 0, 0, 0);
        }
        {
          const int tok = tok_of(base, L, dir, wid * Lq + sc * 16 + fr);
          *(float4*)(ybuf + (size_t)tok * 512 + g * 16 + fq * 4) = make_float4(acc[0], acc[1], acc[2], acc[3]);
        }
      }
    }
    if (pass == 0) {
      E[(wid * 64 + lane) * 2 + 0] = hr;
      E[(wid * 64 + lane) * 2 + 1] = hi;
      __syncthreads();
      float er = h0r, ei = h0i;
      for (int w = 0; w < wid; w++) {
        const float nr = pr_ * er - pi_ * ei + E[(w * 64 + lane) * 2 + 0];
        const float ni = pr_ * ei + pi_ * er + E[(w * 64 + lane) * 2 + 1];
        er = nr; ei = ni;
      }
      hr = er; hi = ei;
    }
  }
  if (ctx && wid == 3) {
    const size_t oi = ((((size_t)seq * 4 + l) * 2 + dir) * 32 + g) * 64 + lane;
    p.out[O_S5R + oi] = hr;
    p.out[O_S5I + oi] = hi;
  }
  __syncthreads();
}


__device__ void ssd_task(const P& p, int l, int seq, int dir, int hd, char* smem) {
  const int tid = otid(), wid = tid >> 6, lane = tid & 63, fr = lane & 15, fq = lane >> 4;
  const int mt = wid >> 1, ph = wid & 1;
  const bool ctx = seq < 16;
  const int L = ctx ? 256 : 1024, base = ctx ? seq * 256 : 4096 + (seq - 16) * 1024;
  const int nch = L >> 5, grp = hd >> 2;
  bfraw* Craw = (bfraw*)smem;
  bfraw* Braw = Craw + 32 * 72;
  bfraw* Hb = Braw + 32 * 72;
  bfraw* BwT = Hb + 64 * 72;
  bfraw* XdtT = BwT + 64 * 40;
  bfraw* Sd = XdtT + 64 * 40;
  float* acs = (float*)(Sd + 32 * 40);
  bfraw* BwL = (bfraw*)(acs + 32);
  bfraw* XdL = BwL + 64 * 40;
  float* ybuf = p.ssdy + (size_t)dir * NT * 512;
  f32x4 H0, H1, H2, H3;
  H0 = f32x4{0.f, 0.f, 0.f, 0.f}; H1 = H0; H2 = H0; H3 = H0;
  if (!ctx) {
    const float* st = p.st_ssd + (((((size_t)(seq - 16) * 4 + l) * 2 + dir) * 8 + hd) * 64) * 64 + wid * 16 + fq * 4;
    const float4 v0 = *(const float4*)(st + (size_t)(0 * 16 + fr) * 64);
    const float4 v1 = *(const float4*)(st + (size_t)(1 * 16 + fr) * 64);
    const float4 v2 = *(const float4*)(st + (size_t)(2 * 16 + fr) * 64);
    const float4 v3 = *(const float4*)(st + (size_t)(3 * 16 + fr) * 64);
    H0 = f32x4{v0.x, v0.y, v0.z, v0.w}; H1 = f32x4{v1.x, v1.y, v1.z, v1.w};
    H2 = f32x4{v2.x, v2.y, v2.z, v2.w}; H3 = f32x4{v3.x, v3.y, v3.z, v3.w};
  }
  const int i0 = (tid >> 4) * 2, c4 = tid & 15;
  float4 rC0, rC1, rB0, rB1, rX0, rX1;
  float rdt0, rdt1, rla = 0.f;
#define SSD_PREFETCH(CH)                                                        \
  {                                                                             \
    const int t0 = tok_of(base, L, dir, (CH) * 32 + i0);                        \
    const int t1 = tok_of(base, L, dir, (CH) * 32 + i0 + 1);                   \
    const float* r0 = p.xbc + (size_t)t0 * 768;                                 \
    const float* r1 = p.xbc + (size_t)t1 * 768;                                 \
    rB0 = *(const float4*)(r0 + 512 + grp * 64 + c4 * 4);                       \
    rB1 = *(const float4*)(r1 + 512 + grp * 64 + c4 * 4);                       \
    rC0 = *(const float4*)(r0 + 640 + grp * 64 + c4 * 4);                       \
    rC1 = *(const float4*)(r1 + 640 + grp * 64 + c4 * 4);                       \
    rX0 = *(const float4*)(r0 + hd * 64 + c4 * 4);                              \
    rX1 = *(const float4*)(r1 + hd * 64 + c4 * 4);                              \
    if (tid < 32) rla = p.dAv[tok_of(base, L, dir, (CH) * 32 + tid) * 16 + dir * 8 + hd]; \
    rdt0 = p.dtv[t0 * 16 + dir * 8 + hd];                                       \
    rdt1 = p.dtv[t1 * 16 + dir * 8 + hd];                                       \
  }
  SSD_PREFETCH(0)
  for (int ch = 0; ch < nch; ch++) {
    __syncthreads();
    if (tid < 64) {
      float g = (lane < 32) ? rla : 0.f;
#pragma unroll
      for (int o = 1; o < 32; o <<= 1) {
        const float t = __shfl_up(g, o, 64);
        if (lane >= o) g += t;
      }
      if (lane < 32) acs[lane] = g;
    }
    __syncthreads();
    const float acl = acs[31];
    const float rac0 = acs[i0], rac1 = acs[i0 + 1];
    {
      *(uint2*)(Craw + i0 * 72 + c4 * 4) = make_uint2(pack2(rC0.x, rC0.y), pack2(rC0.z, rC0.w));
      *(uint2*)(Craw + (i0 + 1) * 72 + c4 * 4) = make_uint2(pack2(rC1.x, rC1.y), pack2(rC1.z, rC1.w));
      *(uint2*)(Braw + i0 * 72 + c4 * 4) = make_uint2(pack2(rB0.x, rB0.y), pack2(rB0.z, rB0.w));
      *(uint2*)(Braw + (i0 + 1) * 72 + c4 * 4) = make_uint2(pack2(rB1.x, rB1.y), pack2(rB1.z, rB1.w));
      const float w0 = __expf(acl - rac0), w1 = __expf(acl - rac1);
#define SSD_HL2(ARR, LO, ROW, V0, V1)                                                         \
  {                                                                                           \
    const float a_ = (V0), b_ = (V1);                                                         \
    const bfraw ha = f2bf(a_), hb = f2bf(b_);                                                 \
    *(unsigned*)(ARR + (ROW) * 40 + i0) = (unsigned)ha | ((unsigned)hb << 16);                \
    *(unsigned*)(LO + (ROW) * 40 + i0) = pack2(a_ - __uint_as_float((unsigned)ha << 16),     \
                                               b_ - __uint_as_float((unsigned)hb << 16));    \
  }
      SSD_HL2(BwT, BwL, c4 * 4 + 0, rB0.x * w0, rB1.x * w1)
      SSD_HL2(BwT, BwL, c4 * 4 + 1, rB0.y * w0, rB1.y * w1)
      SSD_HL2(BwT, BwL, c4 * 4 + 2, rB0.z * w0, rB1.z * w1)
      SSD_HL2(BwT, BwL, c4 * 4 + 3, rB0.w * w0, rB1.w * w1)
      SSD_HL2(XdtT, XdL, c4 * 4 + 0, rX0.x * rdt0, rX1.x * rdt1)
      SSD_HL2(XdtT, XdL, c4 * 4 + 1, rX0.y * rdt0, rX1.y * rdt1)
      SSD_HL2(XdtT, XdL, c4 * 4 + 2, rX0.z * rdt0, rX1.z * rdt1)
      SSD_HL2(XdtT, XdL, c4 * 4 + 3, rX0.w * rdt0, rX1.w * rdt1)
#undef SSD_HL2
      *(uint2*)(Hb + (0 * 16 + fr) * 72 + wid * 16 + fq * 4) = make_uint2(pack2(H0[0], H0[1]), pack2(H0[2], H0[3]));
      *(uint2*)(Hb + (1 * 16 + fr) * 72 + wid * 16 + fq * 4) = make_uint2(pack2(H1[0], H1[1]), pack2(H1[2], H1[3]));
      *(uint2*)(Hb + (2 * 16 + fr) * 72 + wid * 16 + fq * 4) = make_uint2(pack2(H2[0], H2[1]), pack2(H2[2], H2[3]));
      *(uint2*)(Hb + (3 * 16 + fr) * 72 + wid * 16 + fq * 4) = make_uint2(pack2(H3[0], H3[1]), pack2(H3[2], H3[3]));
    }
    __syncthreads();
    if (ch + 1 < nch) SSD_PREFETCH(ch + 1)
    f32x4 sc = f32x4{0.f, 0.f, 0.f, 0.f}, Y0 = sc, Y1 = sc;
#pragma unroll
    for (int ks = 0; ks < 2; ks++) {
      const bf16x8 ac_ = *(const bf16x8*)(Craw + (mt * 16 + fr) * 72 + ks * 32 + fq * 8);
      const bf16x8 bb = *(const bf16x8*)(Braw + (ph * 16 + fr) * 72 + ks * 32 + fq * 8);
      const bf16x8 h0 = *(const bf16x8*)(Hb + ((2 * ph + 0) * 16 + fr) * 72 + ks * 32 + fq * 8);
      const bf16x8 h1 = *(const bf16x8*)(Hb + ((2 * ph + 1) * 16 + fr) * 72 + ks * 32 + fq * 8);
      sc = __builtin_amdgcn_mfma_f32_16x16x32_bf16(bb, ac_, sc, 0, 0, 0);
      Y0 = __builtin_amdgcn_mfma_f32_16x16x32_bf16(h0, ac_, Y0, 0, 0, 0);
      Y1 = __builtin_amdgcn_mfma_f32_16x16x32_bf16(h1, ac_, Y1, 0, 0, 0);
    }
    {
      const int i = mt * 16 + fr;
      const float ai = acs[i];
      float sv[4];
#pragma unroll
      for (int j = 0; j < 4; j++) {
        const int jj = ph * 16 + fq * 4 + j;
        const float d = fminf(ai - acs[jj], 0.f);
        sv[j] = (i >= jj) ? sc[j] * __expf(d) : 0.f;
      }
      *(uint2*)(Sd + i * 40 + ph * 16 + fq * 4) = make_uint2(pack2(sv[0], sv[1]), pack2(sv[2], sv[3]));
    }
    {
      const float e = __expf(acs[mt * 16 + fr]);
      Y0 *= e;
      Y1 *= e;
    }
    __syncthreads();
    {
      const bf16x8 a = *(const bf16x8*)(Sd + (mt * 16 + fr) * 40 + fq * 8);
      const bf16x8 x0 = *(const bf16x8*)(XdtT + ((2 * ph + 0) * 16 + fr) * 40 + fq * 8);
      const bf16x8 x1 = *(const bf16x8*)(XdtT + ((2 * ph + 1) * 16 + fr) * 40 + fq * 8);
      Y0 = __builtin_amdgcn_mfma_f32_16x16x32_bf16(x0, a, Y0, 0, 0, 0);
      Y1 = __builtin_amdgcn_mfma_f32_16x16x32_bf16(x1, a, Y1, 0, 0, 0);
      {
        const int tok = tok_of(base, L, dir, ch * 32 + mt * 16 + fr);
        float* yr = ybuf + (size_t)tok * 512 + hd * 64 + fq * 4;
        *(float4*)(yr + (2 * ph + 0) * 16) = make_float4(Y0[0], Y0[1], Y0[2], Y0[3]);
        *(float4*)(yr + (2 * ph + 1) * 16) = make_float4(Y1[0], Y1[1], Y1[2], Y1[3]);
      }
    }
    {
      const float eL = __expf(acl);
      const bf16x8 a = *(const bf16x8*)(BwT + (wid * 16 + fr) * 40 + fq * 8);
      const bf16x8 x0 = *(const bf16x8*)(XdtT + (0 * 16 + fr) * 40 + fq * 8);
      const bf16x8 x1 = *(const bf16x8*)(XdtT + (1 * 16 + fr) * 40 + fq * 8);
      const bf16x8 x2 = *(const bf16x8*)(XdtT + (2 * 16 + fr) * 40 + fq * 8);
      const bf16x8 x3 = *(const bf16x8*)(XdtT + (3 * 16 + fr) * 40 + fq * 8);
      H0 *= eL; H1 *= eL; H2 *= eL; H3 *= eL;
      const bf16x8 al = *(const bf16x8*)(BwL + (wid * 16 + fr) * 40 + fq * 8);
      const bf16x8 y0 = *(const bf16x8*)(XdL + (0 * 16 + fr) * 40 + fq * 8);
      const bf16x8 y1 = *(const bf16x8*)(XdL + (1 * 16 + fr) * 40 + fq * 8);
      const bf16x8 y2 = *(const bf16x8*)(XdL + (2 * 16 + fr) * 40 + fq * 8);
      const bf16x8 y3 = *(const bf16x8*)(XdL + (3 * 16 + fr) * 40 + fq * 8);
      H0 = __builtin_amdgcn_mfma_f32_16x16x32_bf16(a, x0, H0, 0, 0, 0);
      H1 = __builtin_amdgcn_mfma_f32_16x16x32_bf16(a, x1, H1, 0, 0, 0);
      H2 = __builtin_amdgcn_mfma_f32_16x16x32_bf16(a, x2, H2, 0, 0, 0);
      H3 = __builtin_amdgcn_mfma_f32_16x16x32_bf16(a, x3, H3, 0, 0, 0);
      H0 = __builtin_amdgcn_mfma_f32_16x16x32_bf16(al, x0, H0, 0, 0, 0);
      H1 = __builtin_amdgcn_mfma_f32_16x16x32_bf16(al, x1, H1, 0, 0, 0);
      H2 = __builtin_amdgcn_mfma_f32_16x16x32_bf16(al, x2, H2, 0, 0, 0);
      H3 = __builtin_amdgcn_mfma_f32_16x16x32_bf16(al, x3, H3, 0, 0, 0);
      H0 = __builtin_amdgcn_mfma_f32_16x16x32_bf16(a, y0, H0, 0, 0, 0);
      H1 = __builtin_amdgcn_mfma_f32_16x16x32_bf16(a, y1, H1, 0, 0, 0);
      H2 = __builtin_amdgcn_mfma_f32_16x16x32_bf16(a, y2, H2, 0, 0, 0);
      H3 = __builtin_amdgcn_mfma_f32_16x16x32_bf16(a, y3, H3, 0, 0, 0);
    }
  }
#undef SSD_PREFETCH
  if (ctx) {
    float* st = p.out + O_SSD + (((((size_t)seq * 4 + l) * 2 + dir) * 8 + hd) * 64) * 64 + wid * 16 + fq * 4;
    *(float4*)(st + (size_t)(0 * 16 + fr) * 64) = make_float4(H0[0], H0[1], H0[2], H0[3]);
    *(float4*)(st + (size_t)(1 * 16 + fr) * 64) = make_float4(H1[0], H1[1], H1[2], H1[3]);
    *(float4*)(st + (size_t)(2 * 16 + fr) * 64) = make_float4(H2[0], H2[1], H2[2], H2[3]);
    *(float4*)(st + (size_t)(3 * 16 + fr) * 64) = make_float4(H3[0], H3[1], H3[2], H3[3]);
  }
  __syncthreads();
}


__device__ void dnpre_task(const P& p, int task, char* smem) {
  const int tid = otid(), wid = tid >> 6, lane = tid & 63, fr = lane & 15, fq = lane >> 4;
  const int hd = task & 3, dir = (task >> 2) & 1, cg = task >> 3;
  int base, L;
  if (cg < 128) { base = (cg >> 3) * 256; L = 256; } else { base = 4096 + ((cg - 128) >> 5) * 1024; L = 1024; }
  const int c = cg - (base >> 5);
  const size_t tb = (size_t)task;
  bfraw* Kb = (bfraw*)smem;
  bfraw* Qb = Kb + 32 * 136;
  float* Msm = (float*)(smem + 2 * 32 * 136 * 2);
  float* gcs = Msm + 32 * 36;
  float* bts = gcs + 32;
  if (tid < 64) {
    float g = 0.f, b = 0.f;
    if (lane < 32) {
      const int tok = tok_of(base, L, dir, c * 32 + lane);
      g = p.agv[tok * 8 + dir * 4 + hd];
      b = p.betav[tok * 8 + dir * 4 + hd];
    }
#pragma unroll
    for (int o = 1; o < 32; o <<= 1) {
      const float t = __shfl_up(g, o, 64);
      if (lane >= o) g += t;
    }
    if (lane < 32) { gcs[lane] = g; bts[lane] = b; }
  }
  __syncthreads();
#pragma unroll
  for (int e = 0; e < 4; e++) {
    const int idx = tid + 256 * e, i = idx >> 5, c4 = idx & 31;
    const int tok = tok_of(base, L, dir, c * 32 + i);
    const float* r = p.qkv + (size_t)tok * 1536 + hd * 128 + c4 * 4;
    const float4 q4 = *(const float4*)r;
    const float4 k4 = *(const float4*)(r + 512);
    const float Ai = __expf(gcs[i]);
    *(uint2*)(Kb + i * 136 + c4 * 4) = make_uint2(pack2(k4.x, k4.y), pack2(k4.z, k4.w));
    *(uint2*)(Qb + i * 136 + c4 * 4) = make_uint2(pack2(q4.x, q4.y), pack2(q4.z, q4.w));
    *(uint2*)(p.dn_qa + (tb * 32 + i) * 128 + c4 * 4) = make_uint2(pack2(q4.x * Ai, q4.y * Ai), pack2(q4.z * Ai, q4.w * Ai));
  }
  __syncthreads();
  {
    const int mt = wid >> 1, nt = wid & 1;
    f32x4 accK = f32x4{0.f, 0.f, 0.f, 0.f}, accQ = f32x4{0.f, 0.f, 0.f, 0.f};
#pragma unroll
    for (int ks = 0; ks < 4; ks++) {
      const bf16x8 ak = *(const bf16x8*)(Kb + (mt * 16 + fr) * 136 + ks * 32 + fq * 8);
      const bf16x8 aq = *(const bf16x8*)(Qb + (mt * 16 + fr) * 136 + ks * 32 + fq * 8);
      const bf16x8 bk = *(const bf16x8*)(Kb + (nt * 16 + fr) * 136 + ks * 32 + fq * 8);
      accK = __builtin_amdgcn_mfma_f32_16x16x32_bf16(ak, bk, accK, 0, 0, 0);
      accQ = __builtin_amdgcn_mfma_f32_16x16x32_bf16(aq, bk, accQ, 0, 0, 0);
    }
#pragma unroll
    for (int j = 0; j < 4; j++) {
      const int i = mt * 16 + fq * 4 + j, jj = nt * 16 + fr;
      const float d = fminf(gcs[i] - gcs[jj], 0.f);
      const float dec = (i >= jj) ? __expf(d) : 0.f;
      Msm[i * 36 + jj] = (i > jj) ? bts[i] * accK[j] * dec : 0.f;
      p.dn_qkd[(tb * 32 + i) * 32 + jj] = f2bf(accQ[j] * dec);
    }
  }
  __syncthreads();
  {
    const bool isU = tid < 128;
    const int colofs = isU ? (1024 + hd * 128 + tid) : (512 + hd * 128 + (tid - 128));
    float x[32];
#pragma unroll
    for (int i = 0; i < 32; i++) {
      const int tok = tok_of(base, L, dir, c * 32 + i);
      const float sc = isU ? bts[i] : bts[i] * __expf(gcs[i]);
      x[i] = sc * p.qkv[(size_t)tok * 1536 + colofs];
    }
#pragma unroll
    for (int i = 1; i < 32; i++) {
      float sacc = x[i];
#pragma unroll
      for (int j = 0; j < i; j++) sacc -= Msm[i * 36 + j] * x[j];
      x[i] = sacc;
    }
    if (isU) {
#pragma unroll
      for (int i = 0; i < 32; i++) p.dn_u[(tb * 32 + i) * 128 + tid] = x[i];
    } else {
#pragma unroll
      for (int i = 0; i < 32; i++) p.dn_w[(tb * 32 + i) * 128 + (tid - 128)] = f2bf(x[i]);
    }
  }
  {
    const int dk = tid & 127, half = tid >> 7;
    const float gl = gcs[31];
    unsigned w[8];
#pragma unroll
    for (int e = 0; e < 8; e++) {
      const int j0 = half * 16 + 2 * e;
      const float k0 = p.qkv[(size_t)tok_of(base, L, dir, c * 32 + j0) * 1536 + 512 + hd * 128 + dk] * __expf(gl - gcs[j0]);
      const float k1 = p.qkv[(size_t)tok_of(base, L, dir, c * 32 + j0 + 1) * 1536 + 512 + hd * 128 + dk] * __expf(gl - gcs[j0 + 1]);
      w[e] = pack2(k0, k1);
    }
    bfraw* d = p.dn_kwt + (tb * 128 + dk) * 32 + half * 16;
    *(uint4*)d = make_uint4(w[0], w[1], w[2], w[3]);
    *(uint4*)(d + 8) = make_uint4(w[4], w[5], w[6], w[7]);
    if (tid == 0) p.dn_ac[tb] = __expf(gl);
  }
  __syncthreads();
}

__device__ void dnseq_task(const P& p, int l, int seq, int dir, int hd, int dvs, char* smem) {
  const int tid = otid(), wid = tid >> 6, lane = tid & 63, fr = lane & 15, fq = lane >> 4;
  const int mt = wid >> 1, nt = wid & 1;
  const bool ctx = seq < 16;
  const int L = ctx ? 256 : 1024, base = ctx ? seq * 256 : 4096 + (seq - 16) * 1024;
  const int nch = L >> 5;
  bfraw* Wm = (bfraw*)smem;
  bfraw* QAs = Wm + 32 * 136;
  bfraw* SbT = QAs + 32 * 136;
  bfraw* KwTs = SbT + 32 * 136;
  bfraw* QKds = KwTs + 128 * 40;
  bfraw* VnT = QKds + 32 * 40;
  float* obuf = p.dny + (size_t)dir * NT * 512;
  f32x4 S00, S01, S10, S11;
  S00 = f32x4{0.f, 0.f, 0.f, 0.f}; S01 = S00; S10 = S00; S11 = S00;
  if (!ctx) {
    const float* st = p.st_dn + (((((size_t)(seq - 16) * 4 + l) * 2 + dir) * 4 + hd) * 128) * 128 + dvs * 32 + fr;
#pragma unroll
    for (int j = 0; j < 4; j++) {
      S00[j] = st[(size_t)((2 * wid + 0) * 16 + fq * 4 + j) * 128];
      S01[j] = st[(size_t)((2 * wid + 0) * 16 + fq * 4 + j) * 128 + 16];
      S10[j] = st[(size_t)((2 * wid + 1) * 16 + fq * 4 + j) * 128];
      S11[j] = st[(size_t)((2 * wid + 1) * 16 + fq * 4 + j) * 128 + 16];
    }
  }
  const size_t slot0 = ((size_t)(base >> 5) * 2 + dir) * 4 + hd;
  uint4 rW0, rW1, rQ0, rQ1, rK0, rK1, rD;
  float rU0, rU1, rU2, rU3, rA;
  rD = make_uint4(0, 0, 0, 0);
#define DNS_PREFETCH(CH)                                                                          \
  {                                                                                               \
    const size_t sl = slot0 + (size_t)(CH) * 8;                                                   \
    rW0 = *(const uint4*)(p.dn_w + sl * 4096 + (size_t)tid * 8);                                  \
    rW1 = *(const uint4*)(p.dn_w + sl * 4096 + (size_t)(tid + 256) * 8);                          \
    rQ0 = *(const uint4*)(p.dn_qa + sl * 4096 + (size_t)tid * 8);                                 \
    rQ1 = *(const uint4*)(p.dn_qa + sl * 4096 + (size_t)(tid + 256) * 8);                         \
    rK0 = *(const uint4*)(p.dn_kwt + sl * 4096 + (size_t)tid * 8);                                \
    rK1 = *(const uint4*)(p.dn_kwt + sl * 4096 + (size_t)(tid + 256) * 8);                        \
    if (tid < 128) rD = *(const uint4*)(p.dn_qkd + sl * 1024 + (size_t)tid * 8);                  \
    const float* up = p.dn_u + (sl * 32 + mt * 16 + fq * 4) * 128 + dvs * 32 + nt * 16 + fr;      \
    rU0 = up[0]; rU1 = up[128]; rU2 = up[256]; rU3 = up[384];                                     \
    rA = p.dn_ac[sl];                                                                             \
  }
  DNS_PREFETCH(0)
  for (int ch = 0; ch < nch; ch++) {
    __syncthreads();
    *(uint4*)(Wm + (tid >> 4) * 136 + (tid & 15) * 8) = rW0;
    *(uint4*)(Wm + ((tid >> 4) + 16) * 136 + (tid & 15) * 8) = rW1;
    *(uint4*)(QAs + (tid >> 4) * 136 + (tid & 15) * 8) = rQ0;
    *(uint4*)(QAs + ((tid >> 4) + 16) * 136 + (tid & 15) * 8) = rQ1;
    *(uint4*)(KwTs + (tid >> 2) * 40 + (tid & 3) * 8) = rK0;
    *(uint4*)(KwTs + ((tid >> 2) + 64) * 40 + (tid & 3) * 8) = rK1;
    if (tid < 128) *(uint4*)(QKds + (tid >> 2) * 40 + (tid & 3) * 8) = rD;
    *(uint2*)(SbT + (fr) * 136 + (2 * wid + 0) * 16 + fq * 4) = make_uint2(pack2(S00[0], S00[1]), pack2(S00[2], S00[3]));
    *(uint2*)(SbT + (16 + fr) * 136 + (2 * wid + 0) * 16 + fq * 4) = make_uint2(pack2(S01[0], S01[1]), pack2(S01[2], S01[3]));
    *(uint2*)(SbT + (fr) * 136 + (2 * wid + 1) * 16 + fq * 4) = make_uint2(pack2(S10[0], S10[1]), pack2(S10[2], S10[3]));
    *(uint2*)(SbT + (16 + fr) * 136 + (2 * wid + 1) * 16 + fq * 4) = make_uint2(pack2(S11[0], S11[1]), pack2(S11[2], S11[3]));
    const float u0 = rU0, u1 = rU1, u2 = rU2, u3 = rU3, ac = rA;
    __syncthreads();
    if (ch + 1 < nch) DNS_PREFETCH(ch + 1)
    f32x4 accW = f32x4{0.f, 0.f, 0.f, 0.f}, accQ = f32x4{0.f, 0.f, 0.f, 0.f};
#pragma unroll
    for (int ks = 0; ks < 4; ks++) {
      const bf16x8 aw = *(const bf16x8*)(Wm + (mt * 16 + fr) * 136 + ks * 32 + fq * 8);
      const bf16x8 aq = *(const bf16x8*)(QAs + (mt * 16 + fr) * 136 + ks * 32 + fq * 8);
      const bf16x8 bs = *(const bf16x8*)(SbT + (nt * 16 + fr) * 136 + ks * 32 + fq * 8);
      accW = __builtin_amdgcn_mfma_f32_16x16x32_bf16(aw, bs, accW, 0, 0, 0);
      accQ = __builtin_amdgcn_mfma_f32_16x16x32_bf16(bs, aq, accQ, 0, 0, 0);
    }
    *(uint2*)(VnT + (nt * 16 + fr) * 40 + mt * 16 + fq * 4) =
        make_uint2(pack2(u0 - accW[0], u1 - accW[1]), pack2(u2 - accW[2], u3 - accW[3]));
    __syncthreads();
    {
      const bf16x8 a = *(const bf16x8*)(QKds + (mt * 16 + fr) * 40 + fq * 8);
      const bf16x8 b = *(const bf16x8*)(VnT + (nt * 16 + fr) * 40 + fq * 8);
      accQ = __builtin_amdgcn_mfma_f32_16x16x32_bf16(b, a, accQ, 0, 0, 0);
      {
        const int tok = tok_of(base, L, dir, ch * 32 + mt * 16 + fr);
        *(float4*)(obuf + (size_t)tok * 512 + hd * 128 + dvs * 32 + nt * 16 + fq * 4) = make_float4(accQ[0], accQ[1], accQ[2], accQ[3]);
      }
    }
    {
      const bf16x8 b0 = *(const bf16x8*)(VnT + (fr) * 40 + fq * 8);
      const bf16x8 b1 = *(const bf16x8*)(VnT + (16 + fr) * 40 + fq * 8);
      const bf16x8 a0 = *(const bf16x8*)(KwTs + ((2 * wid + 0) * 16 + fr) * 40 + fq * 8);
      const bf16x8 a1 = *(const bf16x8*)(KwTs + ((2 * wid + 1) * 16 + fr) * 40 + fq * 8);
      S00 *= ac; S01 *= ac; S10 *= ac; S11 *= ac;
      S00 = __builtin_amdgcn_mfma_f32_16x16x32_bf16(a0, b0, S00, 0, 0, 0);
      S01 = __builtin_amdgcn_mfma_f32_16x16x32_bf16(a0, b1, S01, 0, 0, 0);
      S10 = __builtin_amdgcn_mfma_f32_16x16x32_bf16(a1, b0, S10, 0, 0, 0);
      S11 = __builtin_amdgcn_mfma_f32_16x16x32_bf16(a1, b1, S11, 0, 0, 0);
    }
  }
#undef DNS_PREFETCH
  if (ctx) {
    float* st = p.out + O_DN + (((((size_t)seq * 4 + l) * 2 + dir) * 4 + hd) * 128) * 128 + dvs * 32 + fr;
#pragma unroll
    for (int j = 0; j < 4; j++) {
      st[(size_t)((2 * wid + 0) * 16 + fq * 4 + j) * 128] = S00[j];
      st[(size_t)((2 * wid + 0) * 16 + fq * 4 + j) * 128 + 16] = S01[j];
      st[(size_t)((2 * wid + 1) * 16 + fq * 4 + j) * 128] = S10[j];
      st[(size_t)((2 * wid + 1) * 16 + fq * 4 + j) * 128 + 16] = S11[j];
    }
  }
  __syncthreads();
}

__device__ void phase_dnpre(const P& p, char* smem) {
  for (int t = obid(); t < 1536; t += gridDim.x) dnpre_task(p, t, smem);
}

__device__ void phase_scan(const P& p, int l, char* smem) {
  __shared__ int s_task;
  for (;;) {
    if (otid() == 0) s_task = atomicAdd(&p.ctr[l], 1);
    __syncthreads();
    int t = __builtin_amdgcn_readfirstlane(s_task);
    __syncthreads();
    const int NX = 0;
    if (t >= 480) {
      if (t < 480 + NX) {
        t -= 480;
        convert_one(p, l + 1, t, smem);
        continue;
      }
      t -= NX;
      if (t >= 2016) break;
    }
    if (t < 32) {
      ssd_task(p, l, 16 + (t >> 4), (t >> 3) & 1, t & 7, smem);
    } else if (t < 288) {
      t -= 32;
      ssd_task(p, l, t >> 4, (t >> 3) & 1, t & 7, smem);
    } else if (t < 416) {
      t -= 288;
      s5_task(p, l, 16 + (t >> 6), (t >> 5) & 1, t & 31, smem);
    } else if (t < 480) {
      t -= 416;
      dnseq_task(p, l, 16 + (t >> 5), (t >> 4) & 1, (t >> 2) & 3, t & 3, smem);
    } else if (t < 1504) {
      t -= 480;
      s5_task(p, l, t >> 6, (t >> 5) & 1, t & 31, smem);
    } else {
      t -= 1504;
      dnseq_task(p, l, t >> 5, (t >> 4) & 1, (t >> 2) & 3, t & 3, smem);
    }
  }
}

__device__ void phase_post(const P& p, int l) {
  const int wid = otid() >> 6, lane = otid() & 63;
  for (int tok = obid() * 4 + wid; tok < NT; tok += gridDim.x * 4) {
    const float* pr = p.proj + (size_t)tok * INWP;
    const size_t o5 = (size_t)tok * 512;
#pragma unroll
    for (int i = 0; i < 2; i++) {
      const int c = lane * 4 + 256 * i;
      const float4 yf = *(const float4*)(p.s5y + o5 + c), yb = *(const float4*)(p.s5y + (size_t)NT * 512 + o5 + c);
      const float4 d = *(const float4*)(p.s5_d + l * 512 + c), u = *(const float4*)(pr + C_U + c);
      const float y0 = yf.x + yb.x + d.x * u.x, y1 = yf.y + yb.y + d.y * u.y, y2 = yf.z + yb.z + d.z * u.z, y3 = yf.w + yb.w + d.w * u.w;
      *(uint2*)(p.a_s5 + o5 + c) = make_uint2(pack2(gelu_tanh(y0), gelu_tanh(y1)), pack2(gelu_tanh(y2), gelu_tanh(y3)));
    }
    {
      float4 y[2];
      float ss = 0.f;
#pragma unroll
      for (int i = 0; i < 2; i++) {
        const int c = lane * 4 + 256 * i;
        const float4 yf = *(const float4*)(p.ssdy + o5 + c), yb = *(const float4*)(p.ssdy + (size_t)NT * 512 + o5 + c);
        const float4 xs = *(const float4*)(p.xbc + (size_t)tok * 768 + c), z = *(const float4*)(pr + C_Z + c);
        const float dd = p.ssd_d[l * 8 + (c >> 6)];
        y[i].x = (yf.x + yb.x + dd * xs.x) * siluf(z.x);
        y[i].y = (yf.y + yb.y + dd * xs.y) * siluf(z.y);
        y[i].z = (yf.z + yb.z + dd * xs.z) * siluf(z.z);
        y[i].w = (yf.w + yb.w + dd * xs.w) * siluf(z.w);
        ss += y[i].x * y[i].x + y[i].y * y[i].y + y[i].z * y[i].z + y[i].w * y[i].w;
      }
      ss = wave_sum(ss);
      const float r = rsqrtf(ss * (1.f / 512.f) + EPSF);
#pragma unroll
      for (int i = 0; i < 2; i++) {
        const int c = lane * 4 + 256 * i;
        const float4 gn = *(const float4*)(p.ssd_norm_g + l * 512 + c);
        *(uint2*)(p.a_ssd + o5 + c) = make_uint2(pack2(y[i].x * r * gn.x, y[i].y * r * gn.y), pack2(y[i].z * r * gn.z, y[i].w * r * gn.w));
      }
    }
#pragma unroll
    for (int i = 0; i < 2; i++) {
      const int c = lane * 4 + 256 * i;
      const float4 of = *(const float4*)(p.dny + o5 + c), ob = *(const float4*)(p.dny + (size_t)NT * 512 + o5 + c);
      const float o0 = of.x + ob.x, o1 = of.y + ob.y, o2 = of.z + ob.z, o3 = of.w + ob.w;
      const float ss = half_sum(o0 * o0 + o1 * o1 + o2 * o2 + o3 * o3);
      const float r = rsqrtf(ss * (1.f / 128.f) + EPSF);
      const float4 gn = *(const float4*)(p.dn_norm_g + l * 128 + (c & 127));
      const float4 gt = *(const float4*)(pr + C_DNG + c);
      *(uint2*)(p.a_dn + o5 + c) = make_uint2(pack2(o0 * r * gn.x * siluf(gt.x), o1 * r * gn.y * siluf(gt.y)),
                                              pack2(o2 * r * gn.z * siluf(gt.z), o3 * r * gn.w * siluf(gt.w)));
    }
  }
}

__global__ void __launch_bounds__(256, 2) fwd_megakernel(P p) {
  cg::grid_group grid = cg::this_grid();
  __shared__ __attribute__((aligned(16))) char smem[SMEM_BYTES];
  __shared__ uint4 xb_words;
  if (threadIdx.x == 0) xb_words = make_uint4(0u, 0u, 0u, 0u);
  __syncthreads();
  XcdBarrier xb = xcd_barrier_post(p.bar, (volatile LAS unsigned*)&xb_words);
  phase_init(p, smem);
  __syncthreads();
  for (int t = obid(); t < NCONV + 576; t += gridDim.x) {
    if (t < 576) ada_one(p, t / 144, t % 144, smem);
    else convert_one(p, 0, t - 576, smem);
  }
#define GSYNC() xcd_barrier(xb)
  if (p.out == nullptr) grid.sync();
  GSYNC();
  for (int l = 0; l < 4; l++) {
    const float* modl = p.mod + (size_t)l * 3 * 9216;
    const size_t wo = (size_t)(l & 1) * WT_SET;
    phase_normmod(p, l, 0); GSYNC();
    phase_swiglu(p, p.wt_wi + wo, smem); GSYNC();
    phase_resid(p, p.act, p.wt_wo + wo, DFF, modl + 2 * 1024, 0.5f, (l < 3) ? l + 1 : -1, 0, 700, smem); GSYNC();
    phase_normmod(p, l, 1); GSYNC();
    phase_proj(p, wo, smem); GSYNC();
    phase_prep(p, l); GSYNC();
    phase_dnpre(p, smem); GSYNC();
    phase_scan(p, l, smem); GSYNC();
    phase_post(p, l); GSYNC();
    phase_merge(p, wo, smem); GSYNC();
    phase_resid(p, p.h, p.wt_wout + wo, DM, modl + 5 * 1024, 1.0f, (l < 3) ? l + 1 : -1, 700, 950, smem); GSYNC();
    phase_normmod(p, l, 2); GSYNC();
    phase_swiglu(p, p.wt_wi + wo + (size_t)5632 * 1024, smem); GSYNC();
    phase_resid(p, p.act, p.wt_wo + wo + (size_t)1024 * 2816, DFF, modl + 8 * 1024, 0.5f, (l < 3) ? l + 1 : -1, 950, NCONV, smem); GSYNC();
  }
  phase_final(p);
}

extern "C" void kernel_launch(void* const* d_in, const int* in_sizes, int n_in, void* d_out, int out_size, void* d_ws,
                              size_t ws_size, hipStream_t stream) {
  static int grid_blocks = 0;
  if (!grid_blocks) {
    int dev = 0, cus = 0, per_cu = 0;
    hipGetDevice(&dev);
    hipDeviceGetAttribute(&cus, hipDeviceAttributeMultiprocessorCount, dev);
    hipOccupancyMaxActiveBlocksPerMultiprocessor(&per_cu, fwd_megakernel, 256, 0);
    if (per_cu > 2) per_cu = 2;
    if (per_cu < 1) per_cu = 1;
    grid_blocks = cus * per_cu;
  }
  P p{};
  const float** f = (const float**)&p;
  for (int i = 0; i < 37; i++) f[i] = (const float*)d_in[i];
  p.out = (float*)d_out;
  char* w = (char*)d_ws;
  size_t off = 0;
  auto take = [&](size_t bytes) { char* r = w + off; off += (bytes + 255) & ~(size_t)255; return r; };
  p.x = (float*)take((size_t)NT * DM * 4);
  p.mod = (float*)take((size_t)4 * 3 * 9216 * 4);
  p.lbr = (float*)take(16384 * 4);
  p.lbi = (float*)take(16384 * 4);
  p.bbr = (float*)take(16384 * 16 * 4);
  p.bbi = (float*)take(16384 * 16 * 4);
  p.proj = (float*)take((size_t)NT * INWP * 4);
  p.xbc = (float*)take((size_t)NT * 768 * 4);
  p.qkv = (float*)take((size_t)NT * 1536 * 4);
  p.dtv = (float*)take((size_t)NT * 16 * 4);
  p.dAv = (float*)take((size_t)NT * 16 * 4);
  p.betav = (float*)take((size_t)NT * 8 * 4);
  p.agv = (float*)take((size_t)NT * 8 * 4);
  p.qkd = (float*)take((size_t)NT * 4 * 4);
  p.s5y = (float*)take((size_t)2 * NT * 512 * 4);
  p.ssdy = (float*)take((size_t)2 * NT * 512 * 4);
  p.dny = (float*)take((size_t)2 * NT * 512 * 4);
  p.wt_wi = (bfraw*)take((size_t)2 * 5632 * 1024 * 2);
  p.wt_wo = (bfraw*)take((size_t)2 * 1024 * 2816 * 2);
  p.wt_win = (bfraw*)take((size_t)INWP * 1024 * 2);
  p.wt_glu = (bfraw*)take((size_t)2 * 1024 * 512 * 2);
  p.wt_ssdo = (bfraw*)take((size_t)1024 * 512 * 2);
  p.wt_dno = (bfraw*)take((size_t)1024 * 512 * 2);
  p.wt_wout = (bfraw*)take((size_t)1024 * 1024 * 2);
  (void)take(WT_SET * 2);
  p.h = (bfraw*)take((size_t)NT * DM * 2);
  p.act = (bfraw*)take((size_t)NT * DFF * 2);
  p.a_s5 = (bfraw*)take((size_t)NT * 512 * 2);
  p.a_ssd = (bfraw*)take((size_t)NT * 512 * 2);
  p.a_dn = (bfraw*)take((size_t)NT * 512 * 2);
  p.dn_u = (float*)take((size_t)1536 * 32 * 128 * 4);
  p.dn_ac = (float*)take((size_t)1536 * 4);
  p.dn_w = (bfraw*)take((size_t)1536 * 32 * 128 * 2);
  p.dn_qa = (bfraw*)take((size_t)1536 * 32 * 128 * 2);
  p.dn_kwt = (bfraw*)take((size_t)1536 * 128 * 32 * 2);
  p.dn_qkd = (bfraw*)take((size_t)1536 * 32 * 32 * 2);
  p.ssd_ac = (float*)take((size_t)NT * 16 * 4);
  p.ctr = (int*)take(256);
  p.bar = (unsigned*)take(XCD_BAR_WORDS * 4);
  hipMemsetAsync(p.bar, 0, XCD_BAR_WORDS * 4, stream);
  if (off > ws_size) fprintf(stderr, "workspace too small: need %zu have %zu\n", off, ws_size);
  void* args[] = {&p};
  hipError_t e = hipLaunchCooperativeKernel((void*)fwd_megakernel, dim3(grid_blocks), dim3(256), args, 0, stream);
  if (e != hipSuccess) fprintf(stderr, "cooperative launch failed: %s (grid %d)\n", hipGetErrorString(e), grid_blocks);
}
```

```cpp
#include <hip/hip_runtime.h>
#include <hip/hip_bf16.h>
#include <hip/hip_cooperative_groups.h>
#include <cstdio>
namespace cg = cooperative_groups;

typedef unsigned short bfraw;
using bf16x8 = __attribute__((ext_vector_type(8))) short;
using f32x4 = __attribute__((ext_vector_type(4))) float;

#define NT 6144
#define DM 1024
#define DFF 2816
#define INW 6944
#define INWP 7040
#define EPSF 1e-6f
#define SMEM_BYTES 73728
#define LDSK 72
#define WT_SET ((size_t)27656192)

#define C_U 0
#define C_Z 512
#define C_XBC 1024
#define C_DT 1792
#define C_QKV 1808
#define C_BETA 3344
#define C_AR 3352
#define C_DNG 3360
#define C_GATE 3872

#define O_S5R 6291456
#define O_S5I 6553600
#define O_SSD 6815744
#define O_DN 11010048

struct P {
  const float *x_prompt, *x_sample, *st_s5r, *st_s5i, *st_ssd, *st_dn, *c, *c_ctx, *ada_w, *ada_b, *norm_g, *ffn_wi, *ffn_wo, *w_in,
      *s5_lam_re, *s5_lam_im, *s5_log_dt, *s5_b_re, *s5_b_im, *s5_c_re, *s5_c_im, *s5_d, *s5_glu, *ssd_conv_w, *ssd_conv_b,
      *ssd_dt_bias, *ssd_a_log, *ssd_d, *ssd_norm_g, *ssd_w_out, *dn_conv_w, *dn_dt_bias, *dn_a_log, *dn_norm_g, *dn_w_out, *w_out,
      *final_norm_g;
  float* out;
  float *x, *mod, *lbr, *lbi, *bbr, *bbi, *proj, *xbc, *qkv, *dtv, *dAv, *betav, *agv, *qkd, *s5y, *ssdy, *dny;
  bfraw *wt_wi, *wt_wo, *wt_win, *wt_glu, *wt_ssdo, *wt_dno, *wt_wout, *h, *act, *a_s5, *a_ssd, *a_dn;
  int* ctr;
  unsigned* bar;
  float *dn_u, *dn_ac, *ssd_ac;
  bfraw *dn_w, *dn_qa, *dn_kwt, *dn_qkd;
};

__device__ __forceinline__ bfraw f2bf(float f) {
  unsigned u = __float_as_uint(f);
  u += 0x7fffu + ((u >> 16) & 1u);
  return (bfraw)(u >> 16);
}
__device__ __forceinline__ unsigned pack2(float a, float b) { return (unsigned)f2bf(a) | ((unsigned)f2bf(b) << 16); }
__device__ __forceinline__ float siluf(float x) { return x * __builtin_amdgcn_rcpf(1.f + __expf(-x)); }
__device__ __forceinline__ float sigmf(float x) { return __builtin_amdgcn_rcpf(1.f + __expf(-x)); }
__device__ __forceinline__ float softplusf(float x) { return fmaxf(x, 0.f) + log1pf(__expf(-fabsf(x))); }
__device__ __forceinline__ float gelu_tanh(float x) {
  float t = 0.7978845608028654f * (x + 0.044715f * x * x * x);
  return 0.5f * x * (1.f + tanhf(t));
}
__device__ __forceinline__ float wave_sum(float v) {
#pragma unroll
  for (int o = 32; o >= 1; o >>= 1) v += __shfl_xor(v, o, 64);
  return v;
}
template <int CTRL>
__device__ __forceinline__ float dppf(float v) {
  return __builtin_bit_cast(float, __builtin_amdgcn_update_dpp(0, __builtin_bit_cast(int, v), CTRL, 0xF, 0xF, false));
}
__device__ __forceinline__ float red16(float v) {
  v += dppf<0xB1>(v);
  v += dppf<0x4E>(v);
  v += dppf<0x141>(v);
  v += dppf<0x140>(v);
  return v;
}
__device__ __forceinline__ int otid() { int t = threadIdx.x; asm volatile("" : "+v"(t)); return t; }
__device__ __forceinline__ int obid() { int t = blockIdx.x; asm volatile("" : "+s"(t)); return t; }
#define XB_TMO      128
#define XB_XCNT(j)  (256  + 64 * (j))
#define XB_XSUB(j)  (1280 + 64 * (j))
#define XB_XGEN(j)  (2304 + 64 * (j))
#define XB_TOP      3328
#define XB_TOPGEN   3392
#define XCD_BAR_WORDS 3456
#define XB_SPIN_CAP (1u << 18)
#define LAS __attribute__((address_space(3)))

__device__ __forceinline__ unsigned xb_ld(unsigned* p)              { return __hip_atomic_load(p, __ATOMIC_RELAXED, __HIP_MEMORY_SCOPE_AGENT); }
__device__ __forceinline__ unsigned xb_add(unsigned* p, unsigned v) { return __hip_atomic_fetch_add(p, v, __ATOMIC_RELAXED, __HIP_MEMORY_SCOPE_AGENT); }
__device__ __forceinline__ unsigned xb_xcc_id() { return (unsigned)__builtin_amdgcn_s_getreg((3 << 11) | 20) & 0xFu; }
#define XB_SPIN(cond, bar) do { unsigned _sp = 0; while (cond) { __builtin_amdgcn_s_sleep(1); \
    if ((++_sp & 255u) == 0u) { if (xb_ld(&(bar)[XB_TMO])) break; if (_sp > XB_SPIN_CAP) { atomicAdd(&(bar)[XB_TMO], 1u); break; } } } } while (0)

struct XcdBarrier {
    unsigned* bar; unsigned x;
    volatile LAS unsigned* st;
};

__device__ __forceinline__ XcdBarrier xcd_barrier_post(unsigned* bar, volatile LAS unsigned* st) {
    XcdBarrier b; b.bar = bar; b.x = xb_xcc_id(); b.st = st;
    if (threadIdx.x == 0) (void)xb_add(&bar[XB_XCNT(b.x)], 1u);
    return b;
}
__device__ __forceinline__ void xcd_barrier_complete(unsigned* bar, unsigned x, unsigned& nloc, unsigned& nx) {
    const unsigned G = gridDim.x * gridDim.y * gridDim.z;
    unsigned sum, cnt, mine, sp = 0u;
    for (;;) {
        sum = 0u; cnt = 0u; mine = 0u;
#pragma unroll
        for (unsigned j = 0; j < 16; ++j) { const unsigned c = xb_ld(&bar[XB_XCNT(j)]); sum += c; cnt += (c > 0u) ? 1u : 0u; mine = (j == x) ? c : mine; }
        if (sum == G) break;
        __builtin_amdgcn_s_sleep(1);
        if ((++sp & 255u) == 0u) { if (xb_ld(&bar[XB_TMO])) break; if (sp > XB_SPIN_CAP) { atomicAdd(&bar[XB_TMO], 1u); break; } }
    }
    nloc = mine > 0u ? mine : 1u; nx = cnt > 0u ? cnt : 1u;
}

__device__ __forceinline__ void xcd_barrier(const XcdBarrier& b) {
    asm volatile("s_waitcnt vmcnt(0)" ::: "memory");
    __syncthreads();
    if (threadIdx.x == 0) {
        unsigned* bar = b.bar;
        __builtin_amdgcn_s_waitcnt(0);
        unsigned nloc = b.st[0], nx = b.st[1];
        if (nloc == 0u) { xcd_barrier_complete(bar, b.x, nloc, nx); b.st[0] = nloc; b.st[1] = nx; }
        const unsigned old = xb_add(&bar[XB_XSUB(b.x)], 1u);
        const unsigned gen = old / nloc;
        if (old + 1u == (gen + 1u) * nloc) {
            __builtin_amdgcn_fence(__ATOMIC_RELEASE, "agent");
            asm volatile("s_waitcnt vmcnt(0)" ::: "memory");
            const unsigned og = xb_add(&bar[XB_TOP], 1u);
            const unsigned tg = og / nx;
            if (og + 1u == (tg + 1u) * nx) xb_add(&bar[XB_TOPGEN], 1u);
            else XB_SPIN(xb_ld(&bar[XB_TOPGEN]) == tg, bar);
            __builtin_amdgcn_fence(__ATOMIC_ACQUIRE, "agent");
            xb_add(&bar[XB_XGEN(b.x)], 1u);
            asm volatile("s_waitcnt vmcnt(0)" ::: "memory");
        } else {
            XB_SPIN(xb_ld(&bar[XB_XGEN(b.x)]) == gen, bar);
            __builtin_amdgcn_fence(__ATOMIC_ACQUIRE, "agent");
            asm volatile("s_waitcnt vmcnt(0)" ::: "memory");
        }
    }
    __syncthreads();
}


__device__ __forceinline__ int cond_of(int row) { return row < 4096 ? 0 : 1 + ((row - 4096) >> 10); }

template <int NSUB, bool PAIRED, int MSUB = 4>
__device__ __forceinline__ void gemm_tile(const bfraw* __restrict__ A, int lda, const bfraw* __restrict__ Bt, int ldb, int K,
                                          int row0, int brow0, bfraw* sA, bfraw* sB, f32x4 (&acc)[MSUB][NSUB]) {
  constexpr int BN = NSUB * 32;
  const int tid = otid(), wid = tid >> 6, lane = tid & 63, wr = wid >> 1, wc = wid & 1, fr = lane & 15, fq = lane >> 4;
  uint4 ra0, ra1, ra2, ra3, rb0, rb1, rb2, rb3;
  const int cr = tid >> 3, cc = tid & 7;
  const bfraw* ga = A + (size_t)(row0 + cr) * lda + cc * 8;
  const bfraw* gb = Bt + (size_t)(brow0 + cr) * ldb + cc * 8;
  const int nk = K >> 6;
  rb2 = make_uint4(0, 0, 0, 0); rb3 = rb2; ra3 = rb2;
#define GLOAD(KO)                                               \
  ra0 = *(const uint4*)(ga + (size_t)(0) * lda + (KO));         \
  ra1 = *(const uint4*)(ga + (size_t)(32) * lda + (KO));        \
  ra2 = *(const uint4*)(ga + (size_t)(64) * lda + (KO));        \
  if (MSUB == 4) ra3 = *(const uint4*)(ga + (size_t)(96) * lda + (KO)); \
  rb0 = *(const uint4*)(gb + (size_t)(0) * ldb + (KO));         \
  rb1 = *(const uint4*)(gb + (size_t)(32) * ldb + (KO));        \
  if (NSUB == 4) {                                              \
    rb2 = *(const uint4*)(gb + (size_t)(64) * ldb + (KO));      \
    rb3 = *(const uint4*)(gb + (size_t)(96) * ldb + (KO));      \
  }
  GLOAD(0)
  int bcol[NSUB];
#pragma unroll
  for (int n = 0; n < NSUB; n++) bcol[n] = PAIRED ? ((n >> 1) * 64 + wc * 32 + (n & 1) * 16) : (wc * (NSUB * 16) + n * 16);
  for (int kt = 0; kt < nk; kt++) {
    const int buf = kt & 1;
    bfraw* a_s = sA + buf * (128 * LDSK);
    bfraw* b_s = sB + buf * (BN * LDSK);
    *(uint4*)(a_s + (cr + 0) * LDSK + cc * 8) = ra0;
    *(uint4*)(a_s + (cr + 32) * LDSK + cc * 8) = ra1;
    *(uint4*)(a_s + (cr + 64) * LDSK + cc * 8) = ra2;
    if (MSUB == 4) *(uint4*)(a_s + (cr + 96) * LDSK + cc * 8) = ra3;
    *(uint4*)(b_s + (cr + 0) * LDSK + cc * 8) = rb0;
    *(uint4*)(b_s + (cr + 32) * LDSK + cc * 8) = rb1;
    if (NSUB == 4) {
      *(uint4*)(b_s + (cr + 64) * LDSK + cc * 8) = rb2;
      *(uint4*)(b_s + (cr + 96) * LDSK + cc * 8) = rb3;
    }
    __syncthreads();
    if (kt + 1 < nk) { GLOAD((kt + 1) * 64) }
    __builtin_amdgcn_sched_barrier(0);
#pragma unroll
    for (int ks = 0; ks < 2; ks++) {
      bf16x8 af[MSUB], bfv[NSUB];
#pragma unroll
      for (int m = 0; m < MSUB; m++) af[m] = *(const bf16x8*)(a_s + (wr * (MSUB * 16) + m * 16 + fr) * LDSK + ks * 32 + fq * 8);
#pragma unroll
      for (int n = 0; n < NSUB; n++) bfv[n] = *(const bf16x8*)(b_s + (bcol[n] + fr) * LDSK + ks * 32 + fq * 8);
      __builtin_amdgcn_s_setprio(1);
#pragma unroll
      for (int m = 0; m < MSUB; m++)
#pragma unroll
        for (int n = 0; n < NSUB; n++) acc[m][n] = __builtin_amdgcn_mfma_f32_16x16x32_bf16(bfv[n], af[m], acc[m][n], 0, 0, 0);
      __builtin_amdgcn_s_setprio(0);
    }
  }
  __syncthreads();
#undef GLOAD
}

#define GEMM_IDS                                                                                              \
  const int tid = otid(), wid = tid >> 6, lane = tid & 63, wr = wid >> 1, wc = wid & 1, fr = lane & 15, \
            fq = lane >> 4;                                                                                   \
  bfraw* sA = (bfraw*)smem;                                                                                   \
  bfraw* sB = sA + 2 * 128 * LDSK;                                                                            \
  (void)tid; (void)wid; (void)lane; (void)wr; (void)wc; (void)fr; (void)fq;

__device__ void convert_one(const P& p, int l, int t, char* smem);
__device__ void phase_swiglu(const P& p, const bfraw* Wt, char* smem) {
  GEMM_IDS
  for (int tile = obid(); tile < 48 * 44; tile += gridDim.x) {
    const int mt = tile % 48, nt = tile / 48;
    f32x4 acc[4][4];
#pragma unroll
    for (int m = 0; m < 4; m++)
#pragma unroll
      for (int n = 0; n < 4; n++) acc[m][n] = f32x4{0.f, 0.f, 0.f, 0.f};
    gemm_tile<4, true>(p.h, DM, Wt, DM, DM, mt * 128, nt * 128, sA, sB, acc);
#pragma unroll
    for (int m = 0; m < 4; m++)
#pragma unroll
      for (int n = 0; n < 2; n++) {
        const int row = mt * 128 + wr * 64 + m * 16 + fr;
        const int col = nt * 64 + wc * 32 + n * 16 + fq * 4;
        const f32x4 a = acc[m][n], b = acc[m][n + 2];
        *(uint2*)(p.act + (size_t)row * DFF + col) =
            make_uint2(pack2(siluf(a[0]) * b[0], siluf(a[1]) * b[1]), pack2(siluf(a[2]) * b[2], siluf(a[3]) * b[3]));
      }
  }
}

__device__ void phase_resid(const P& p, const bfraw* A, const bfraw* Wt, int K, const float* gate  ,
                            float scale, int cl  , int cbeg, int cend, char* smem) {
  GEMM_IDS
  if (cl >= 0) {
    if (gridDim.x > 384) {
      if (obid() >= 384) {
        for (int t = cbeg + (obid() - 384); t < cend; t += (gridDim.x - 384)) convert_one(p, cl, t, smem);
        return;
      }
    } else {
      for (int t = cbeg + obid(); t < cend; t += gridDim.x) convert_one(p, cl, t, smem);
    }
  }
  for (int tile = obid(); tile < 48 * 8; tile += gridDim.x) {
    const int mt = tile % 48, nt = tile / 48;
    f32x4 acc[4][4];
#pragma unroll
    for (int m = 0; m < 4; m++)
#pragma unroll
      for (int n = 0; n < 4; n++) acc[m][n] = f32x4{0.f, 0.f, 0.f, 0.f};
    gemm_tile<4, false>(A, K, Wt, K, K, mt * 128, nt * 128, sA, sB, acc);
#pragma unroll
    for (int m = 0; m < 4; m++)
#pragma unroll
      for (int n = 0; n < 4; n++) {
        const int row = mt * 128 + wr * 64 + m * 16 + fr;
        const int col = nt * 128 + wc * 64 + n * 16 + fq * 4;
        const float4 g = *(const float4*)(gate + cond_of(row) * 9216 + col);
        float4* xp = (float4*)(p.x + (size_t)row * DM + col);
        float4 xv = *xp;
        xv.x += scale * g.x * acc[m][n][0];
        xv.y += scale * g.y * acc[m][n][1];
        xv.z += scale * g.z * acc[m][n][2];
        xv.w += scale * g.w * acc[m][n][3];
        *xp = xv;
      }
  }
}

__device__ void phase_proj(const P& p, size_t wo, char* smem) {
  GEMM_IDS
  for (int tile = obid(); tile < 48 * 55; tile += gridDim.x) {
    const int mt = tile % 48, nt = tile / 48;
    f32x4 acc[4][4];
#pragma unroll
    for (int m = 0; m < 4; m++)
#pragma unroll
      for (int n = 0; n < 4; n++) acc[m][n] = f32x4{0.f, 0.f, 0.f, 0.f};
    gemm_tile<4, false>(p.h, DM, p.wt_win + wo, DM, DM, mt * 128, nt * 128, sA, sB, acc);
#pragma unroll
    for (int m = 0; m < 4; m++)
#pragma unroll
      for (int n = 0; n < 4; n++) {
        const int row = mt * 128 + wr * 64 + m * 16 + fr;
        const int col = nt * 128 + wc * 64 + n * 16 + fq * 4;
        *(float4*)(p.proj + (size_t)row * INWP + col) = make_float4(acc[m][n][0], acc[m][n][1], acc[m][n][2], acc[m][n][3]);
      }
  }
}

__device__ void phase_merge(const P& p, size_t wo, char* smem) {
  GEMM_IDS
  for (int tile = obid(); tile < 64 * 16; tile += gridDim.x) {
    const int mt = tile & 63, nt = tile >> 6;
    f32x4 acc[3][2], acc2[3][2], mg[3][2];
#pragma unroll
    for (int m = 0; m < 3; m++)
#pragma unroll
      for (int n = 0; n < 2; n++) { acc[m][n] = f32x4{0.f, 0.f, 0.f, 0.f}; acc2[m][n] = f32x4{0.f, 0.f, 0.f, 0.f}; }
    gemm_tile<2, false, 3>(p.a_s5, 512, p.wt_glu + wo, 512, 512, mt * 96, nt * 64, sA, sB, acc);
    gemm_tile<2, false, 3>(p.a_s5, 512, p.wt_glu + wo + 1024 * 512, 512, 512, mt * 96, nt * 64, sA, sB, acc2);
#pragma unroll
    for (int m = 0; m < 3; m++)
#pragma unroll
      for (int n = 0; n < 2; n++) {
        const int row = mt * 96 + wr * 48 + m * 16 + fr;
        const int col = nt * 64 + wc * 32 + n * 16 + fq * 4;
        const float4 g = *(const float4*)(p.proj + (size_t)row * INWP + C_GATE + col);
        mg[m][n][0] = sigmf(g.x) * acc[m][n][0] * sigmf(acc2[m][n][0]);
        mg[m][n][1] = sigmf(g.y) * acc[m][n][1] * sigmf(acc2[m][n][1]);
        mg[m][n][2] = sigmf(g.z) * acc[m][n][2] * sigmf(acc2[m][n][2]);
        mg[m][n][3] = sigmf(g.w) * acc[m][n][3] * sigmf(acc2[m][n][3]);
        acc[m][n] = f32x4{0.f, 0.f, 0.f, 0.f};
      }
    gemm_tile<2, false, 3>(p.a_ssd, 512, p.wt_ssdo + wo, 512, 512, mt * 96, nt * 64, sA, sB, acc);
#pragma unroll
    for (int m = 0; m < 3; m++)
#pragma unroll
      for (int n = 0; n < 2; n++) {
        const int row = mt * 96 + wr * 48 + m * 16 + fr;
        const int col = nt * 64 + wc * 32 + n * 16 + fq * 4;
        const float4 g = *(const float4*)(p.proj + (size_t)row * INWP + C_GATE + 1024 + col);
        mg[m][n][0] += sigmf(g.x) * acc[m][n][0];
        mg[m][n][1] += sigmf(g.y) * acc[m][n][1];
        mg[m][n][2] += sigmf(g.z) * acc[m][n][2];
        mg[m][n][3] += sigmf(g.w) * acc[m][n][3];
        acc[m][n] = f32x4{0.f, 0.f, 0.f, 0.f};
      }
    gemm_tile<2, false, 3>(p.a_dn, 512, p.wt_dno + wo, 512, 512, mt * 96, nt * 64, sA, sB, acc);
#pragma unroll
    for (int m = 0; m < 3; m++)
#pragma unroll
      for (int n = 0; n < 2; n++) {
        const int row = mt * 96 + wr * 48 + m * 16 + fr;
        const int col = nt * 64 + wc * 32 + n * 16 + fq * 4;
        const float4 g = *(const float4*)(p.proj + (size_t)row * INWP + C_GATE + 2048 + col);
        *(uint2*)(p.h + (size_t)row * DM + col) =
            make_uint2(pack2(mg[m][n][0] + sigmf(g.x) * acc[m][n][0], mg[m][n][1] + sigmf(g.y) * acc[m][n][1]),
                       pack2(mg[m][n][2] + sigmf(g.z) * acc[m][n][2], mg[m][n][3] + sigmf(g.w) * acc[m][n][3]));
      }
  }
}

__device__ void conv_tile(const float* __restrict__ src, int K, int Nsrc, bfraw* __restrict__ dst, int kt, int nt, int scol0,
                          float* tile  ) {
  const int tid = otid();
  {
    const int r = tid >> 4, c4 = tid & 15;
#pragma unroll
    for (int rr = 0; rr < 4; rr++) {
      const int k = rr * 16 + r;
      float4 v = make_float4(0.f, 0.f, 0.f, 0.f);
      if (scol0 + c4 * 4 + 3 < Nsrc) v = *(const float4*)(src + (size_t)(kt * 64 + k) * Nsrc + scol0 + c4 * 4);
      tile[k * 65 + c4 * 4 + 0] = v.x;
      tile[k * 65 + c4 * 4 + 1] = v.y;
      tile[k * 65 + c4 * 4 + 2] = v.z;
      tile[k * 65 + c4 * 4 + 3] = v.w;
    }
  }
  __syncthreads();
  {
    const int n = tid >> 2, kq = tid & 3;
    unsigned w[8];
#pragma unroll
    for (int e = 0; e < 8; e++) {
      const float a = tile[(kq * 16 + 2 * e) * 65 + n], b = tile[(kq * 16 + 2 * e + 1) * 65 + n];
      w[e] = (unsigned)f2bf(a) | ((unsigned)f2bf(b) << 16);
    }
    bfraw* d = dst + (size_t)(nt * 64 + n) * K + kt * 64 + kq * 16;
    *(uint4*)(d) = make_uint4(w[0], w[1], w[2], w[3]);
    *(uint4*)(d + 8) = make_uint4(w[4], w[5], w[6], w[7]);
  }
  __syncthreads();
}

__device__ void conv_tile4(const float* __restrict__ src, int K, int Nsrc, bfraw* __restrict__ dst, int kt, int nt0, int ntiles,
                           bool paired, float* tile  ) {
  const int tid = otid();
  const int r = tid >> 4, c4 = tid & 15;
  float4 v[4][4];
#pragma unroll
  for (int q = 0; q < 4; q++) {
    const int nt = nt0 + q;
    const int scol0 = paired ? ((nt & 1) * 2816 + (nt >> 1) * 64) : nt * 64;
    const bool ok = (nt < ntiles) && (scol0 + c4 * 4 + 3 < Nsrc);
#pragma unroll
    for (int rr = 0; rr < 4; rr++) {
      v[q][rr] = make_float4(0.f, 0.f, 0.f, 0.f);
      if (ok) v[q][rr] = *(const float4*)(src + (size_t)(kt * 64 + rr * 16 + r) * Nsrc + scol0 + c4 * 4);
    }
  }
#pragma unroll
  for (int q = 0; q < 4; q++) {
    const int nt = nt0 + q;
    if (nt < ntiles) {
#pragma unroll
      for (int rr = 0; rr < 4; rr++) {
        const int k = rr * 16 + r;
        tile[k * 65 + c4 * 4 + 0] = v[q][rr].x;
        tile[k * 65 + c4 * 4 + 1] = v[q][rr].y;
        tile[k * 65 + c4 * 4 + 2] = v[q][rr].z;
        tile[k * 65 + c4 * 4 + 3] = v[q][rr].w;
      }
      __syncthreads();
      {
        const int n = tid >> 2, kq = tid & 3;
        unsigned w[8];
#pragma unroll
        for (int e = 0; e < 8; e++) {
          const float x0 = tile[(kq * 16 + 2 * e) * 65 + n], x1 = tile[(kq * 16 + 2 * e + 1) * 65 + n];
          w[e] = (unsigned)f2bf(x0) | ((unsigned)f2bf(x1) << 16);
        }
        bfraw* d = dst + (size_t)(nt * 64 + n) * K + kt * 64 + kq * 16;
        *(uint4*)(d) = make_uint4(w[0], w[1], w[2], w[3]);
        *(uint4*)(d + 8) = make_uint4(w[4], w[5], w[6], w[7]);
      }
      __syncthreads();
    }
  }
}

#define NCONV 1696
__device__ void convert_one(const P& p, int l, int t, char* smem) {
  float* tile = (float*)smem;
  const size_t wo = (size_t)(l & 1) * WT_SET;
  int u = t;
  if (u < 704) {
    const int s = u / 352; u -= s * 352;
    const int kt = u & 15, nq = u >> 4;
    conv_tile4(p.ffn_wi + (size_t)(l * 2 + s) * 1024 * 5632, 1024, 5632, p.wt_wi + wo + (size_t)s * 5632 * 1024, kt, nq * 4, 88, true, tile);
  } else if (u < 1056) {
    u -= 704;
    const int s = u / 176; u -= s * 176;
    const int kt = u % 44, nq = u / 44;
    conv_tile4(p.ffn_wo + (size_t)(l * 2 + s) * 2816 * 1024, 2816, 1024, p.wt_wo + wo + (size_t)s * 1024 * 2816, kt, nq * 4, 16, false, tile);
  } else if (u < 1504) {
    u -= 1056;
    const int kt = u & 15, nq = u >> 4;
    conv_tile4(p.w_in + (size_t)l * 1024 * 6944, 1024, 6944, p.wt_win + wo, kt, nq * 4, 110, false, tile);
  } else if (u < 1568) {
    u -= 1504;
    const int s = u >> 5; u &= 31;
    const int kt = u & 7, nq = u >> 3;
    conv_tile4(p.s5_glu + (size_t)(l * 2 + s) * 512 * 1024, 512, 1024, p.wt_glu + wo + (size_t)s * 1024 * 512, kt, nq * 4, 16, false, tile);
  } else if (u < 1600) {
    u -= 1568;
    const int kt = u & 7, nq = u >> 3;
    conv_tile4(p.ssd_w_out + (size_t)l * 512 * 1024, 512, 1024, p.wt_ssdo + wo, kt, nq * 4, 16, false, tile);
  } else if (u < 1632) {
    u -= 1600;
    const int kt = u & 7, nq = u >> 3;
    conv_tile4(p.dn_w_out + (size_t)l * 512 * 1024, 512, 1024, p.wt_dno + wo, kt, nq * 4, 16, false, tile);
  } else {
    u -= 1632;
    const int kt = u & 15, nq = u >> 4;
    conv_tile4(p.w_out + (size_t)l * 1024 * 1024, 1024, 1024, p.wt_wout + wo, kt, nq * 4, 16, false, tile);
  }
}

__device__ void phase_init(const P& p, char* smem) {
  const int tid = otid(), wid = tid >> 6, lane = tid & 63;
  const int gtid = obid() * 256 + tid, gsz = gridDim.x * 256;
  if (gtid < 8) p.ctr[gtid] = 0;
  for (int i = gtid; i < NT * DM / 4; i += gsz) {
    float4 v = (i < 4096 * 256) ? ((const float4*)p.x_prompt)[i] : ((const float4*)p.x_sample)[i - 4096 * 256];
    ((float4*)p.x)[i] = v;
  }
  for (int i = gtid; i < 4 * 2 * 32 * 64; i += gsz) {
    const int ldg = i >> 6;
    const float dt = __expf(p.s5_log_dt[ldg]);
    const float lr = p.s5_lam_re[i], li = p.s5_lam_im[i];
    const float mag = expf(lr * dt);
    const float br = mag * cosf(li * dt), bi = mag * sinf(li * dt);
    const float den = lr * lr + li * li;
    const float cr = ((br - 1.f) * lr + bi * li) / den;
    const float ci = (bi * lr - (br - 1.f) * li) / den;
    p.lbr[i] = br;
    p.lbi[i] = bi;
#pragma unroll
    for (int k = 0; k < 16; k++) {
      const float b_re = p.s5_b_re[(size_t)i * 16 + k], b_im = p.s5_b_im[(size_t)i * 16 + k];
      p.bbr[(size_t)i * 16 + k] = cr * b_re - ci * b_im;
      p.bbi[(size_t)i * 16 + k] = cr * b_im + ci * b_re;
    }
  }
}

__device__ void ada_one(const P& p, int l, int cb, char* smem) {
  const int tid = otid(), lane = tid & 63;
  float* sc = (float*)smem;
  float* red = sc + 3 * 1024;
  for (int i = tid; i < 3 * 1024; i += 256) {
    const int c = i >> 10, k = i & 1023;
    const float v = (c == 0) ? p.c_ctx[k] : p.c[(c - 1) * 1024 + k];
    sc[i] = siluf(v);
  }
  __syncthreads();
  {
    const int kg = tid >> 4, c4 = tid & 15;
    const float* w = p.ada_w + (size_t)l * 1024 * 9216 + cb * 64 + c4 * 4 + (size_t)(kg * 64) * 9216;
    float4 a0 = make_float4(0.f, 0.f, 0.f, 0.f), a1 = a0, a2 = a0;
#pragma unroll 16
    for (int kk = 0; kk < 64; kk++) {
      const float4 wv = *(const float4*)(w + (size_t)kk * 9216);
      const int k = kg * 64 + kk;
      const float s0 = sc[k], s1 = sc[1024 + k], s2 = sc[2048 + k];
      a0.x += s0 * wv.x; a0.y += s0 * wv.y; a0.z += s0 * wv.z; a0.w += s0 * wv.w;
      a1.x += s1 * wv.x; a1.y += s1 * wv.y; a1.z += s1 * wv.z; a1.w += s1 * wv.w;
      a2.x += s2 * wv.x; a2.y += s2 * wv.y; a2.z += s2 * wv.z; a2.w += s2 * wv.w;
    }
    *(float4*)(red + (kg * 3 + 0) * 64 + c4 * 4) = a0;
    *(float4*)(red + (kg * 3 + 1) * 64 + c4 * 4) = a1;
    *(float4*)(red + (kg * 3 + 2) * 64 + c4 * 4) = a2;
    __syncthreads();
    if (tid < 192) {
      const int c = tid >> 6;
      float sacc = 0.f;
#pragma unroll
      for (int g = 0; g < 16; g++) sacc += red[(g * 3 + c) * 64 + lane];
      p.mod[(size_t)(l * 3 + c) * 9216 + cb * 64 + lane] = sacc + p.ada_b[(size_t)l * 9216 + cb * 64 + lane];
    }
    __syncthreads();
  }
}

__device__ void phase_normmod(const P& p, int l, int sub) {
  const int wid = otid() >> 6, lane = otid() & 63;
  const float* g = p.norm_g + (size_t)(l * 3 + sub) * 1024;
  for (int tok = obid() * 4 + wid; tok < NT; tok += gridDim.x * 4) {
    const float* xr = p.x + (size_t)tok * DM;
    float4 v[4];
    float ss = 0.f;
#pragma unroll
    for (int i = 0; i < 4; i++) {
      v[i] = *(const float4*)(xr + lane * 4 + i * 256);
      ss += v[i].x * v[i].x + v[i].y * v[i].y + v[i].z * v[i].z + v[i].w * v[i].w;
    }
    ss = wave_sum(ss);
    const float r = rsqrtf(ss * (1.f / 1024.f) + EPSF);
    const float* md = p.mod + (size_t)(l * 3 + cond_of(tok)) * 9216 + sub * 3 * 1024;
#pragma unroll
    for (int i = 0; i < 4; i++) {
      const int c = lane * 4 + i * 256;
      const float4 gg = *(const float4*)(g + c);
      const float4 sh = *(const float4*)(md + c);
      const float4 scv = *(const float4*)(md + 1024 + c);
      const float o0 = v[i].x * r * gg.x * (1.f + scv.x) + sh.x;
      const float o1 = v[i].y * r * gg.y * (1.f + scv.y) + sh.y;
      const float o2 = v[i].z * r * gg.z * (1.f + scv.z) + sh.z;
      const float o3 = v[i].w * r * gg.w * (1.f + scv.w) + sh.w;
      uint2 o;
      o.x = (unsigned)f2bf(o0) | ((unsigned)f2bf(o1) << 16);
      o.y = (unsigned)f2bf(o2) | ((unsigned)f2bf(o3) << 16);
      *(uint2*)(p.h + (size_t)tok * DM + c) = o;
    }
  }
}

__device__ void phase_final(const P& p) {
  const int wid = otid() >> 6, lane = otid() & 63;
  for (int tok = obid() * 4 + wid; tok < NT; tok += gridDim.x * 4) {
    const float* xr = p.x + (size_t)tok * DM;
    float4 v[4];
    float ss = 0.f;
#pragma unroll
    for (int i = 0; i < 4; i++) {
      v[i] = *(const float4*)(xr + lane * 4 + i * 256);
      ss += v[i].x * v[i].x + v[i].y * v[i].y + v[i].z * v[i].z + v[i].w * v[i].w;
    }
    ss = wave_sum(ss);
    const float r = rsqrtf(ss * (1.f / 1024.f) + EPSF);
#pragma unroll
    for (int i = 0; i < 4; i++) {
      const int c = lane * 4 + i * 256;
      const float4 gg = *(const float4*)(p.final_norm_g + c);
      float4 o = make_float4(v[i].x * r * gg.x, v[i].y * r * gg.y, v[i].z * r * gg.z, v[i].w * r * gg.w);
      *(float4*)(p.out + (size_t)tok * DM + c) = o;
    }
  }
}

__device__ __forceinline__ float half_sum(float v) {
#pragma unroll
  for (int o = 16; o >= 1; o >>= 1) v += __shfl_xor(v, o, 64);
  return v;
}
__device__ __forceinline__ float4 conv3(const float4 w0, const float4 w1, const float4 w2, const float4 xm, const float4 x0,
                                        const float4 xp, float fp, float fn) {
  float4 r;
  r.x = w0.x * fp * xm.x + w1.x * x0.x + w2.x * fn * xp.x;
  r.y = w0.y * fp * xm.y + w1.y * x0.y + w2.y * fn * xp.y;
  r.z = w0.z * fp * xm.z + w1.z * x0.z + w2.z * fn * xp.z;
  r.w = w0.w * fp * xm.w + w1.w * x0.w + w2.w * fn * xp.w;
  return r;
}
__device__ void phase_prep(const P& p, int l) {
  const int wid = otid() >> 6, lane = otid() & 63;
  const float* cw = p.ssd_conv_w + (size_t)l * 3 * 768;
  const float* cb = p.ssd_conv_b + (size_t)l * 768;
  const float* dw = p.dn_conv_w + (size_t)l * 3 * 1536;
  for (int tok = obid() * 4 + wid; tok < NT; tok += gridDim.x * 4) {
    bool hp, hn;
    if (tok < 4096) { const int t = tok & 255; hp = t > 0; hn = t < 255; }
    else { const int w = (tok - 4096) & 63; hp = w > 0; hn = w < 63; }
    const float* pr = p.proj + (size_t)tok * INWP;
    const float* pm = hp ? pr - INWP : pr;
    const float* pn = hn ? pr + INWP : pr;
    const float fp = hp ? 1.f : 0.f, fn = hn ? 1.f : 0.f;
#pragma unroll
    for (int i = 0; i < 3; i++) {
      const int c = lane * 4 + 256 * i;
      float4 v = conv3(*(const float4*)(cw + c), *(const float4*)(cw + 768 + c), *(const float4*)(cw + 1536 + c),
                       *(const float4*)(pm + C_XBC + c), *(const float4*)(pr + C_XBC + c), *(const float4*)(pn + C_XBC + c), fp, fn);
      const float4 bb = *(const float4*)(cb + c);
      v.x = siluf(v.x + bb.x); v.y = siluf(v.y + bb.y); v.z = siluf(v.z + bb.z); v.w = siluf(v.w + bb.w);
      *(float4*)(p.xbc + (size_t)tok * 768 + c) = v;
    }
#pragma unroll
    for (int hpair = 0; hpair < 2; hpair++) {
      const int hh = hpair * 2 + (lane >> 5);
      const int cq = hh * 128 + (lane & 31) * 4, ck = 512 + cq, cv = 1024 + cq;
      float4 q = conv3(*(const float4*)(dw + cq), *(const float4*)(dw + 1536 + cq), *(const float4*)(dw + 3072 + cq),
                       *(const float4*)(pm + C_QKV + cq), *(const float4*)(pr + C_QKV + cq), *(const float4*)(pn + C_QKV + cq), fp, fn);
      float4 k = conv3(*(const float4*)(dw + ck), *(const float4*)(dw + 1536 + ck), *(const float4*)(dw + 3072 + ck),
                       *(const float4*)(pm + C_QKV + ck), *(const float4*)(pr + C_QKV + ck), *(const float4*)(pn + C_QKV + ck), fp, fn);
      float4 v = conv3(*(const float4*)(dw + cv), *(const float4*)(dw + 1536 + cv), *(const float4*)(dw + 3072 + cv),
                       *(const float4*)(pm + C_QKV + cv), *(const float4*)(pr + C_QKV + cv), *(const float4*)(pn + C_QKV + cv), fp, fn);
      q.x = siluf(q.x); q.y = siluf(q.y); q.z = siluf(q.z); q.w = siluf(q.w);
      k.x = siluf(k.x); k.y = siluf(k.y); k.z = siluf(k.z); k.w = siluf(k.w);
      v.x = siluf(v.x); v.y = siluf(v.y); v.z = siluf(v.z); v.w = siluf(v.w);
      const float sq = half_sum(q.x * q.x + q.y * q.y + q.z * q.z + q.w * q.w);
      const float sk = half_sum(k.x * k.x + k.y * k.y + k.z * k.z + k.w * k.w);
      const float rq = rsqrtf(sq + EPSF) * 0.08838834764831845f;
      const float rk = rsqrtf(sk + EPSF);
      *(float4*)(p.qkv + (size_t)tok * 1536 + cq) = make_float4(q.x * rq, q.y * rq, q.z * rq, q.w * rq);
      *(float4*)(p.qkv + (size_t)tok * 1536 + ck) = make_float4(k.x * rk, k.y * rk, k.z * rk, k.w * rk);
      *(float4*)(p.qkv + (size_t)tok * 1536 + cv) = v;
    }
    if (lane < 16) {
      const float dt = softplusf(pr[C_DT + lane] + p.ssd_dt_bias[l * 16 + lane]);
      const float a = -__expf(p.ssd_a_log[l * 16 + lane]);
      p.dtv[tok * 16 + lane] = dt;
      p.dAv[tok * 16 + lane] = dt * a;
    }
    if (lane < 8) {
      p.betav[tok * 8 + lane] = sigmf(pr[C_BETA + lane]);
      const float g = -__expf(p.dn_a_log[l * 8 + lane]) * softplusf(pr[C_AR + lane] + p.dn_dt_bias[l * 8 + lane]);
      p.agv[tok * 8 + lane] = g;
    }
  }
}

__device__ __forceinline__ int tok_of(int base, int L, int dir, int tpos) { return base + (dir ? (L - 1 - tpos) : tpos); }


__device__ void s5_task(const P& p, int l, int seq, int dir, int g, char* smem) {
  const int tid = otid(), wid = tid >> 6, lane = tid & 63, fr = lane & 15, fq = lane >> 4;
  const bool ctx = seq < 16;
  const int L = ctx ? 256 : 1024, base = ctx ? seq * 256 : 4096 + (seq - 16) * 1024, Lq = L >> 2;
  const int ldg = (l * 2 + dir) * 32 + g;
  const int pidx = ldg * 64 + lane;
  const float lr = p.lbr[pidx], li = p.lbi[pidx];
  bf16x8 bbf[8];
#pragma unroll
  for (int nt = 0; nt < 8; nt++) {
    const float* src = ((nt < 4) ? p.bbr : p.bbi) + ((size_t)ldg * 64 + (nt & 3) * 16 + fr) * 16;
#pragma unroll
    for (int e = 0; e < 8; e++) {
      const int k = fq * 8 + e;
      const float v = src[k & 15];
      bbf[nt][e] = (short)f2bf((k < 16) ? v : 0.f);
    }
  }
  bf16x8 cf[4];
#pragma unroll
  for (int ks = 0; ks < 4; ks++)
#pragma unroll
    for (int e = 0; e < 8; e++) {
      const int k = ks * 32 + fq * 8 + e;
      const float v = (k < 64) ? p.s5_c_re[((size_t)ldg * 16 + fr) * 64 + k] : -p.s5_c_im[((size_t)ldg * 16 + fr) * 64 + (k - 64)];
      cf[ks][e] = (short)f2bf(v);
    }
  float pr_ = lr, pi_ = li;
  const int nsq = ctx ? 6 : 8;
  for (int i = 0; i < nsq; i++) {
    const float nr = pr_ * pr_ - pi_ * pi_, ni = 2.f * pr_ * pi_;
    pr_ = nr; pi_ = ni;
  }
  bfraw* U16b = (bfraw*)smem + wid * 256;
  float* BUT = (float*)(smem + 2048) + wid * (128 * 20);
  bfraw* H16 = (bfraw*)(smem + 2048 + 4 * 128 * 20 * 4) + wid * (16 * 136);
  float* E = (float*)(smem + 2048 + 4 * 128 * 20 * 4 + 4 * 16 * 136 * 2);
  float* ybuf = p.s5y + (size_t)dir * NT * 512;
  const int nsc = Lq >> 4;
  float h0r = 0.f, h0i = 0.f;
  if (!ctx) {
    const size_t si = ((((size_t)(seq - 16) * 4 + l) * 2 + dir) * 32 + g) * 64 + lane;
    h0r = p.st_s5r[si];
    h0i = p.st_s5i[si];
  }
  float hr = 0.f, hi = 0.f;
  for (int pass = 0; pass < 2; pass++) {
    const int utt = lane >> 2, uq = lane & 3;
    float4 up = *(const float4*)(p.proj + (size_t)tok_of(base, L, dir, wid * Lq + utt) * INWP + C_U + g * 16 + uq * 4);
    for (int sc = 0; sc < nsc; sc++) {
      *(uint2*)(U16b + utt * 16 + uq * 4) = make_uint2(pack2(up.x, up.y), pack2(up.z, up.w));
      __syncthreads();
      if (sc + 1 < nsc) up = *(const float4*)(p.proj + (size_t)tok_of(base, L, dir, wid * Lq + (sc + 1) * 16 + utt) * INWP + C_U + g * 16 + uq * 4);
      {
        bf16x8 a = bf16x8{0, 0, 0, 0, 0, 0, 0, 0};
        if (fq < 2) a = *(const bf16x8*)(U16b + fr * 16 + fq * 8);
#pragma unroll
        for (int nt = 0; nt < 8; nt++) {
          f32x4 acc = f32x4{0.f, 0.f, 0.f, 0.f};
          acc = __builtin_amdgcn_mfma_f32_16x16x32_bf16(a, bbf[nt], acc, 0, 0, 0);
          *(float4*)(BUT + (nt * 16 + fr) * 20 + fq * 4) = make_float4(acc[0], acc[1], acc[2], acc[3]);
        }
      }
      __syncthreads();
      float br[16], bi[16];
#pragma unroll
      for (int c = 0; c < 4; c++) {
        const float4 t0 = *(const float4*)(BUT + lane * 20 + c * 4);
        const float4 t1 = *(const float4*)(BUT + (64 + lane) * 20 + c * 4);
        br[c * 4 + 0] = t0.x; br[c * 4 + 1] = t0.y; br[c * 4 + 2] = t0.z; br[c * 4 + 3] = t0.w;
        bi[c * 4 + 0] = t1.x; bi[c * 4 + 1] = t1.y; bi[c * 4 + 2] = t1.z; bi[c * 4 + 3] = t1.w;
      }
#pragma unroll
      for (int s = 0; s < 16; s++) {
        const float nr = lr * hr - li * hi + br[s];
        const float ni = lr * hi + li * hr + bi[s];
        hr = nr; hi = ni;
        if (pass == 1) {
          H16[s * 136 + lane] = f2bf(hr);
          H16[s * 136 + 64 + lane] = f2bf(hi);
        }
      }
      if (pass == 1) {
        __syncthreads();
        f32x4 acc = f32x4{0.f, 0.f, 0.f, 0.f};
#pragma unroll
        for (int ks = 0; ks < 4; ks++) {
          const bf16x8 a = *(const bf16x8*)(H16 + fr * 136 + ks * 32 + fq * 8);
          acc = __builtin_amdgcn_mfma_f32_16x16x32_bf16(cf[ks], a, acc, 0, 0, 0);
        }
        {
          const int tok = tok_of(base, L, dir, wid * Lq + sc * 16 + fr);
          *(float4*)(ybuf + (size_t)tok * 512 + g * 16 + fq * 4) = make_float4(acc[0], acc[1], acc[2], acc[3]);
        }
      }
    }
    if (pass == 0) {
      E[(wid * 64 + lane) * 2 + 0] = hr;
      E[(wid * 64 + lane) * 2 + 1] = hi;
      __syncthreads();
      float er = h0r, ei = h0i;
      for (int w = 0; w < wid; w++) {
        const float nr = pr_ * er - pi_ * ei + E[(w * 64 + lane) * 2 + 0];
        const float ni = pr_ * ei + pi_ * er + E[(w * 64 + lane) * 2 + 1];
        er = nr; ei = ni;
      }
      hr = er; hi = ei;
    }
  }
  if (ctx && wid == 3) {
    const size_t oi = ((((size_t)seq * 4 + l) * 2 + dir) * 32 + g) * 64 + lane;
    p.out[O_S5R + oi] = hr;
    p.out[O_S5I + oi] = hi;
  }
  __syncthreads();
}


__device__ void ssd_task(const P& p, int l, int seq, int dir, int hd, char* smem) {
  const int tid = otid(), wid = tid >> 6, lane = tid & 63, fr = lane & 15, fq = lane >> 4;
  const int mt = wid >> 1, ph = wid & 1;
  const bool ctx = seq < 16;
  const int L = ctx ? 256 : 1024, base = ctx ? seq * 256 : 4096 + (seq - 16) * 1024;
  const int nch = L >> 5, grp = hd >> 2;
  bfraw* Craw = (bfraw*)smem;
  bfraw* Braw = Craw + 32 * 72;
  bfraw* Hb = Braw + 32 * 72;
  bfraw* BwT = Hb + 64 * 72;
  bfraw* XdtT = BwT + 64 * 40;
  bfraw* Sd = XdtT + 64 * 40;
  float* acs = (float*)(Sd + 32 * 40);
  bfraw* BwL = (bfraw*)(acs + 32);
  bfraw* XdL = BwL + 64 * 40;
  float* ybuf = p.ssdy + (size_t)dir * NT * 512;
  f32x4 H0, H1, H2, H3;
  H0 = f32x4{0.f, 0.f, 0.f, 0.f}; H1 = H0; H2 = H0; H3 = H0;
  if (!ctx) {
    const float* st = p.st_ssd + (((((size_t)(seq - 16) * 4 + l) * 2 + dir) * 8 + hd) * 64) * 64 + wid * 16 + fq * 4;
    const float4 v0 = *(const float4*)(st + (size_t)(0 * 16 + fr) * 64);
    const float4 v1 = *(const float4*)(st + (size_t)(1 * 16 + fr) * 64);
    const float4 v2 = *(const float4*)(st + (size_t)(2 * 16 + fr) * 64);
    const float4 v3 = *(const float4*)(st + (size_t)(3 * 16 + fr) * 64);
    H0 = f32x4{v0.x, v0.y, v0.z, v0.w}; H1 = f32x4{v1.x, v1.y, v1.z, v1.w};
    H2 = f32x4{v2.x, v2.y, v2.z, v2.w}; H3 = f32x4{v3.x, v3.y, v3.z, v3.w};
  }
  const int i0 = (tid >> 4) * 2, c4 = tid & 15;
  float4 rC0, rC1, rB0, rB1, rX0, rX1;
  float rdt0, rdt1, rla = 0.f;
#define SSD_PREFETCH(CH)                                                        \
  {                                                                             \
    const int t0 = tok_of(base, L, dir, (CH) * 32 + i0);                        \
    const int t1 = tok_of(base, L, dir, (CH) * 32 + i0 + 1);                   \
    const float* r0 = p.xbc + (size_t)t0 * 768;                                 \
    const float* r1 = p.xbc + (size_t)t1 * 768;                                 \
    rB0 = *(const float4*)(r0 + 512 + grp * 64 + c4 * 4);                       \
    rB1 = *(const float4*)(r1 + 512 + grp * 64 + c4 * 4);                       \
    rC0 = *(const float4*)(r0 + 640 + grp * 64 + c4 * 4);                       \
    rC1 = *(const float4*)(r1 + 640 + grp * 64 + c4 * 4);                       \
    rX0 = *(const float4*)(r0 + hd * 64 + c4 * 4);                              \
    rX1 = *(const float4*)(r1 + hd * 64 + c4 * 4);                              \
    if (tid < 32) rla = p.dAv[tok_of(base, L, dir, (CH) * 32 + tid) * 16 + dir * 8 + hd]; \
    rdt0 = p.dtv[t0 * 16 + dir * 8 + hd];                                       \
    rdt1 = p.dtv[t1 * 16 + dir * 8 + hd];                                       \
  }
  SSD_PREFETCH(0)
  for (int ch = 0; ch < nch; ch++) {
    __syncthreads();
    if (tid < 64) {
      float g = (lane < 32) ? rla : 0.f;
#pragma unroll
      for (int o = 1; o < 32; o <<= 1) {
        const float t = __shfl_up(g, o, 64);
        if (lane >= o) g += t;
      }
      if (lane < 32) acs[lane] = g;
    }
    __syncthreads();
    const float acl = acs[31];
    const float rac0 = acs[i0], rac1 = acs[i0 + 1];
    {
      *(uint2*)(Craw + i0 * 72 + c4 * 4) = make_uint2(pack2(rC0.x, rC0.y), pack2(rC0.z, rC0.w));
      *(uint2*)(Craw + (i0 + 1) * 72 + c4 * 4) = make_uint2(pack2(rC1.x, rC1.y), pack2(rC1.z, rC1.w));
      *(uint2*)(Braw + i0 * 72 + c4 * 4) = make_uint2(pack2(rB0.x, rB0.y), pack2(rB0.z, rB0.w));
      *(uint2*)(Braw + (i0 + 1) * 72 + c4 * 4) = make_uint2(pack2(rB1.x, rB1.y), pack2(rB1.z, rB1.w));
      const float w0 = __expf(acl - rac0), w1 = __expf(acl - rac1);
#define SSD_HL2(ARR, LO, ROW, V0, V1)                                                         \
  {                                                                                           \
    const float a_ = (V0), b_ = (V1);                                                         \
    const bfraw ha = f2bf(a_), hb = f2bf(b_);                                                 \
    *(unsigned*)(ARR + (ROW) * 40 + i0) = (unsigned)ha | ((unsigned)hb << 16);                \
    *(unsigned*)(LO + (ROW) * 40 + i0) = pack2(a_ - __uint_as_float((unsigned)ha << 16),     \
                                               b_ - __uint_as_float((unsigned)hb << 16));    \
  }
      SSD_HL2(BwT, BwL, c4 * 4 + 0, rB0.x * w0, rB1.x * w1)
      SSD_HL2(BwT, BwL, c4 * 4 + 1, rB0.y * w0, rB1.y * w1)
      SSD_HL2(BwT, BwL, c4 * 4 + 2, rB0.z * w0, rB1.z * w1)
      SSD_HL2(BwT, BwL, c4 * 4 + 3, rB0.w * w0, rB1.w * w1)
      SSD_HL2(XdtT, XdL, c4 * 4 + 0, rX0.x * rdt0, rX1.x * rdt1)
      SSD_HL2(XdtT, XdL, c4 * 4 + 1, rX0.y * rdt0, rX1.y * rdt1)
      SSD_HL2(XdtT, XdL, c4 * 4 + 2, rX0.z * rdt0, rX1.z * rdt1)
      SSD_HL2(XdtT, XdL, c4 * 4 + 3, rX0.w * rdt0, rX1.w * rdt1)
#undef SSD_HL2
      *(uint2*)(Hb + (0 * 16 + fr) * 72 + wid * 16 + fq * 4) = make_uint2(pack2(H0[0], H0[1]), pack2(H0[2], H0[3]));
      *(uint2*)(Hb + (1 * 16 + fr) * 72 + wid * 16 + fq * 4) = make_uint2(pack2(H1[0], H1[1]), pack2(H1[2], H1[3]));
      *(uint2*)(Hb + (2 * 16 + fr) * 72 + wid * 16 + fq * 4) = make_uint2(pack2(H2[0], H2[1]), pack2(H2[2], H2[3]));
      *(uint2*)(Hb + (3 * 16 + fr) * 72 + wid * 16 + fq * 4) = make_uint2(pack2(H3[0], H3[1]), pack2(H3[2], H3[3]));
    }
    __syncthreads();
    if (ch + 1 < nch) SSD_PREFETCH(ch + 1)
    f32x4 sc = f32x4{0.f, 0.f, 0.f, 0.f}, Y0 = sc, Y1 = sc;
#pragma unroll
    for (int ks = 0; ks < 2; ks++) {
      const bf16x8 ac_ = *(const bf16x8*)(Craw + (mt * 16 + fr) * 72 + ks * 32 + fq * 8);
      const bf16x8 bb = *(const bf16x8*)(Braw + (ph * 16 + fr) * 72 + ks * 32 + fq * 8);
      const bf16x8 h0 = *(const bf16x8*)(Hb + ((2 * ph + 0) * 16 + fr) * 72 + ks * 32 + fq * 8);
      const bf16x8 h1 = *(const bf16x8*)(Hb + ((2 * ph + 1) * 16 + fr) * 72 + ks * 32 + fq * 8);
      sc = __builtin_amdgcn_mfma_f32_16x16x32_bf16(bb, ac_, sc, 0, 0, 0);
      Y0 = __builtin_amdgcn_mfma_f32_16x16x32_bf16(h0, ac_, Y0, 0, 0, 0);
      Y1 = __builtin_amdgcn_mfma_f32_16x16x32_bf16(h1, ac_, Y1, 0, 0, 0);
    }
    {
      const int i = mt * 16 + fr;
      const float ai = acs[i];
      float sv[4];
#pragma unroll
      for (int j = 0; j < 4; j++) {
        const int jj = ph * 16 + fq * 4 + j;
        const float d = fminf(ai - acs[jj], 0.f);
        sv[j] = (i >= jj) ? sc[j] * __expf(d) : 0.f;
      }
      *(uint2*)(Sd + i * 40 + ph * 16 + fq * 4) = make_uint2(pack2(sv[0], sv[1]), pack2(sv[2], sv[3]));
    }
    {
      const float e = __expf(acs[mt * 16 + fr]);
      Y0 *= e;
      Y1 *= e;
    }
    __syncthreads();
    {
      const bf16x8 a = *(const bf16x8*)(Sd + (mt * 16 + fr) * 40 + fq * 8);
      const bf16x8 x0 = *(const bf16x8*)(XdtT + ((2 * ph + 0) * 16 + fr) * 40 + fq * 8);
      const bf16x8 x1 = *(const bf16x8*)(XdtT + ((2 * ph + 1) * 16 + fr) * 40 + fq * 8);
      Y0 = __builtin_amdgcn_mfma_f32_16x16x32_bf16(x0, a, Y0, 0, 0, 0);
      Y1 = __builtin_amdgcn_mfma_f32_16x16x32_bf16(x1, a, Y1, 0, 0, 0);
      {
        const int tok = tok_of(base, L, dir, ch * 32 + mt * 16 + fr);
        float* yr = ybuf + (size_t)tok * 512 + hd * 64 + fq * 4;
        *(float4*)(yr + (2 * ph + 0) * 16) = make_float4(Y0[0], Y0[1], Y0[2], Y0[3]);
        *(float4*)(yr + (2 * ph + 1) * 16) = make_float4(Y1[0], Y1[1], Y1[2], Y1[3]);
      }
    }
    {
      const float eL = __expf(acl);
      const bf16x8 a = *(const bf16x8*)(BwT + (wid * 16 + fr) * 40 + fq * 8);
      const bf16x8 x0 = *(const bf16x8*)(XdtT + (0 * 16 + fr) * 40 + fq * 8);
      const bf16x8 x1 = *(const bf16x8*)(XdtT + (1 * 16 + fr) * 40 + fq * 8);
      const bf16x8 x2 = *(const bf16x8*)(XdtT + (2 * 16 + fr) * 40 + fq * 8);
      const bf16x8 x3 = *(const bf16x8*)(XdtT + (3 * 16 + fr) * 40 + fq * 8);
      H0 *= eL; H1 *= eL; H2 *= eL; H3 *= eL;
      const bf16x8 al = *(const bf16x8*)(BwL + (wid * 16 + fr) * 40 + fq * 8);
      const bf16x8 y0 = *(const bf16x8*)(XdL + (0 * 16 + fr) * 40 + fq * 8);
      const bf16x8 y1 = *(const bf16x8*)(XdL + (1 * 16 + fr) * 40 + fq * 8);
      const bf16x8 y2 = *(const bf16x8*)(XdL + (2 * 16 + fr) * 40 + fq * 8);
      const bf16x8 y3 = *(const bf16x8*)(XdL + (3 * 16 + fr) * 40 + fq * 8);
      H0 = __builtin_amdgcn_mfma_f32_16x16x32_bf16(a, x0, H0, 0, 0, 0);
      H1 = __builtin_amdgcn_mfma_f32_16x16x32_bf16(a, x1, H1, 0, 0, 0);
      H2 = __builtin_amdgcn_mfma_f32_16x16x32_bf16(a, x2, H2, 0, 0, 0);
      H3 = __builtin_amdgcn_mfma_f32_16x16x32_bf16(a, x3, H3, 0, 0, 0);
      H0 = __builtin_amdgcn_mfma_f32_16x16x32_bf16(al, x0, H0, 0, 0, 0);
      H1 = __builtin_amdgcn_mfma_f32_16x16x32_bf16(al, x1, H1, 0, 0, 0);
      H2 = __builtin_amdgcn_mfma_f32_16x16x32_bf16(al, x2, H2, 0, 0, 0);
      H3 = __builtin_amdgcn_mfma_f32_16x16x32_bf16(al, x3, H3, 0, 0, 0);
      H0 = __builtin_amdgcn_mfma_f32_16x16x32_bf16(a, y0, H0, 0, 0, 0);
      H1 = __builtin_amdgcn_mfma_f32_16x16x32_bf16(a, y1, H1, 0, 0, 0);
      H2 = __builtin_amdgcn_mfma_f32_16x16x32_bf16(a, y2, H2, 0, 0, 0);
      H3 = __builtin_amdgcn_mfma_f32_16x16x32_bf16(a, y3, H3, 0, 0, 0);
    }
  }
#undef SSD_PREFETCH
  if (ctx) {
    float* st = p.out + O_SSD + (((((size_t)seq * 4 + l) * 2 + dir) * 8 + hd) * 64) * 64 + wid * 16 + fq * 4;
    *(float4*)(st + (size_t)(0 * 16 + fr) * 64) = make_float4(H0[0], H0[1], H0[2], H0[3]);
    *(float4*)(st + (size_t)(1 * 16 + fr) * 64) = make_float4(H1[0], H1[1], H1[2], H1[3]);
    *(float4*)(st + (size_t)(2 * 16 + fr) * 64) = make_float4(H2[0], H2[1], H2[2], H2[3]);
    *(float4*)(st + (size_t)(3 * 16 + fr) * 64) = make_float4(H3[0], H3[1], H3[2], H3[3]);
  }
  __syncthreads();
}


__device__ void dnpre_task(const P& p, int task, char* smem) {
  const int tid = otid(), wid = tid >> 6, lane = tid & 63, fr = lane & 15, fq = lane >> 4;
  const int hd = task & 3, dir = (task >> 2) & 1, cg = task >> 3;
  int base, L;
  if (cg < 128) { base = (cg >> 3) * 256; L = 256; } else { base = 4096 + ((cg - 128) >> 5) * 1024; L = 1024; }
  const int c = cg - (base >> 5);
  const size_t tb = (size_t)task;
  bfraw* Kb = (bfraw*)smem;
  bfraw* Qb = Kb + 32 * 136;
  float* Msm = (float*)(smem + 2 * 32 * 136 * 2);
  float* gcs = Msm + 32 * 36;
  float* bts = gcs + 32;
  if (tid < 64) {
    float g = 0.f, b = 0.f;
    if (lane < 32) {
      const int tok = tok_of(base, L, dir, c * 32 + lane);
      g = p.agv[tok * 8 + dir * 4 + hd];
      b = p.betav[tok * 8 + dir * 4 + hd];
    }
#pragma unroll
    for (int o = 1; o < 32; o <<= 1) {
      const float t = __shfl_up(g, o, 64);
      if (lane >= o) g += t;
    }
    if (lane < 32) { gcs[lane] = g; bts[lane] = b; }
  }
  __syncthreads();
#pragma unroll
  for (int e = 0; e < 4; e++) {
    const int idx = tid + 256 * e, i = idx >> 5, c4 = idx & 31;
    const int tok = tok_of(base, L, dir, c * 32 + i);
    const float* r = p.qkv + (size_t)tok * 1536 + hd * 128 + c4 * 4;
    const float4 q4 = *(const float4*)r;
    const float4 k4 = *(const float4*)(r + 512);
    const float Ai = __expf(gcs[i]);
    *(uint2*)(Kb + i * 136 + c4 * 4) = make_uint2(pack2(k4.x, k4.y), pack2(k4.z, k4.w));
    *(uint2*)(Qb + i * 136 + c4 * 4) = make_uint2(pack2(q4.x, q4.y), pack2(q4.z, q4.w));
    *(uint2*)(p.dn_qa + (tb * 32 + i) * 128 + c4 * 4) = make_uint2(pack2(q4.x * Ai, q4.y * Ai), pack2(q4.z * Ai, q4.w * Ai));
  }
  __syncthreads();
  {
    const int mt = wid >> 1, nt = wid & 1;
    f32x4 accK = f32x4{0.f, 0.f, 0.f, 0.f}, accQ = f32x4{0.f, 0.f, 0.f, 0.f};
#pragma unroll
    for (int ks = 0; ks < 4; ks++) {
      const bf16x8 ak = *(const bf16x8*)(Kb + (mt * 16 + fr) * 136 + ks * 32 + fq * 8);
      const bf16x8 aq = *(const bf16x8*)(Qb + (mt * 16 + fr) * 136 + ks * 32 + fq * 8);
      const bf16x8 bk = *(const bf16x8*)(Kb + (nt * 16 + fr) * 136 + ks * 32 + fq * 8);
      accK = __builtin_amdgcn_mfma_f32_16x16x32_bf16(ak, bk, accK, 0, 0, 0);
      accQ = __builtin_amdgcn_mfma_f32_16x16x32_bf16(aq, bk, accQ, 0, 0, 0);
    }
#pragma unroll
    for (int j = 0; j < 4; j++) {
      const int i = mt * 16 + fq * 4 + j, jj = nt * 16 + fr;
      const float d = fminf(gcs[i] - gcs[jj], 0.f);
      const float dec = (i >= jj) ? __expf(d) : 0.f;
      Msm[i * 36 + jj] = (i > jj) ? bts[i] * accK[j] * dec : 0.f;
      p.dn_qkd[(tb * 32 + i) * 32 + jj] = f2bf(accQ[j] * dec);
    }
  }
  __syncthreads();
  {
    const bool isU = tid < 128;
    const int colofs = isU ? (1024 + hd * 128 + tid) : (512 + hd * 128 + (tid - 128));
    float x[32];
#pragma unroll
    for (int i = 0; i < 32; i++) {
      const int tok = tok_of(base, L, dir, c * 32 + i);
      const float sc = isU ? bts[i] : bts[i] * __expf(gcs[i]);
      x[i] = sc * p.qkv[(size_t)tok * 1536 + colofs];
    }
#pragma unroll
    for (int i = 1; i < 32; i++) {
      float sacc = x[i];
#pragma unroll
      for (int j = 0; j < i; j++) sacc -= Msm[i * 36 + j] * x[j];
      x[i] = sacc;
    }
    if (isU) {
#pragma unroll
      for (int i = 0; i < 32; i++) p.dn_u[(tb * 32 + i) * 128 + tid] = x[i];
    } else {
#pragma unroll
      for (int i = 0; i < 32; i++) p.dn_w[(tb * 32 + i) * 128 + (tid - 128)] = f2bf(x[i]);
    }
  }
  {
    const int dk = tid & 127, half = tid >> 7;
    const float gl = gcs[31];
    unsigned w[8];
#pragma unroll
    for (int e = 0; e < 8; e++) {
      const int j0 = half * 16 + 2 * e;
      const float k0 = p.qkv[(size_t)tok_of(base, L, dir, c * 32 + j0) * 1536 + 512 + hd * 128 + dk] * __expf(gl - gcs[j0]);
      const float k1 = p.qkv[(size_t)tok_of(base, L, dir, c * 32 + j0 + 1) * 1536 + 512 + hd * 128 + dk] * __expf(gl - gcs[j0 + 1]);
      w[e] = pack2(k0, k1);
    }
    bfraw* d = p.dn_kwt + (tb * 128 + dk) * 32 + half * 16;
    *(uint4*)d = make_uint4(w[0], w[1], w[2], w[3]);
    *(uint4*)(d + 8) = make_uint4(w[4], w[5], w[6], w[7]);
    if (tid == 0) p.dn_ac[tb] = __expf(gl);
  }
  __syncthreads();
}

__device__ void dnseq_task(const P& p, int l, int seq, int dir, int hd, int dvs, char* smem) {
  const int tid = otid(), wid = tid >> 6, lane = tid & 63, fr = lane & 15, fq = lane >> 4;
  const int mt = wid >> 1, nt = wid & 1;
  const bool ctx = seq < 16;
  const int L = ctx ? 256 : 1024, base = ctx ? seq * 256 : 4096 + (seq - 16) * 1024;
  const int nch = L >> 5;
  bfraw* Wm = (bfraw*)smem;
  bfraw* QAs = Wm + 32 * 136;
  bfraw* SbT = QAs + 32 * 136;
  bfraw* KwTs = SbT + 32 * 136;
  bfraw* QKds = KwTs + 128 * 40;
  bfraw* VnT = QKds + 32 * 40;
  float* obuf = p.dny + (size_t)dir * NT * 512;
  f32x4 S00, S01, S10, S11;
  S00 = f32x4{0.f, 0.f, 0.f, 0.f}; S01 = S00; S10 = S00; S11 = S00;
  if (!ctx) {
    const float* st = p.st_dn + (((((size_t)(seq - 16) * 4 + l) * 2 + dir) * 4 + hd) * 128) * 128 + dvs * 32 + fr;
#pragma unroll
    for (int j = 0; j < 4; j++) {
      S00[j] = st[(size_t)((2 * wid + 0) * 16 + fq * 4 + j) * 128];
      S01[j] = st[(size_t)((2 * wid + 0) * 16 + fq * 4 + j) * 128 + 16];
      S10[j] = st[(size_t)((2 * wid + 1) * 16 + fq * 4 + j) * 128];
      S11[j] = st[(size_t)((2 * wid + 1) * 16 + fq * 4 + j) * 128 + 16];
    }
  }
  const size_t slot0 = ((size_t)(base >> 5) * 2 + dir) * 4 + hd;
  uint4 rW0, rW1, rQ0, rQ1, rK0, rK1, rD;
  float rU0, rU1, rU2, rU3, rA;
  rD = make_uint4(0, 0, 0, 0);
#define DNS_PREFETCH(CH)                                                                          \
  {                                                                                               \
    const size_t sl = slot0 + (size_t)(CH) * 8;                                                   \
    rW0 = *(const uint4*)(p.dn_w + sl * 4096 + (size_t)tid * 8);                                  \
    rW1 = *(const uint4*)(p.dn_w + sl * 4096 + (size_t)(tid + 256) * 8);                          \
    rQ0 = *(const uint4*)(p.dn_qa + sl * 4096 + (size_t)tid * 8);                                 \
    rQ1 = *(const uint4*)(p.dn_qa + sl * 4096 + (size_t)(tid + 256) * 8);                         \
    rK0 = *(const uint4*)(p.dn_kwt + sl * 4096 + (size_t)tid * 8);                                \
    rK1 = *(const uint4*)(p.dn_kwt + sl * 4096 + (size_t)(tid + 256) * 8);                        \
    if (tid < 128) rD = *(const uint4*)(p.dn_qkd + sl * 1024 + (size_t)tid * 8);                  \
    const float* up = p.dn_u + (sl * 32 + mt * 16 + fq * 4) * 128 + dvs * 32 + nt * 16 + fr;      \
    rU0 = up[0]; rU1 = up[128]; rU2 = up[256]; rU3 = up[384];                                     \
    rA = p.dn_ac[sl];                                                                             \
  }
  DNS_PREFETCH(0)
  for (int ch = 0; ch < nch; ch++) {
    __syncthreads();
    *(uint4*)(Wm + (tid >> 4) * 136 + (tid & 15) * 8) = rW0;
    *(uint4*)(Wm + ((tid >> 4) + 16) * 136 + (tid & 15) * 8) = rW1;
    *(uint4*)(QAs + (tid >> 4) * 136 + (tid & 15) * 8) = rQ0;
    *(uint4*)(QAs + ((tid >> 4) + 16) * 136 + (tid & 15) * 8) = rQ1;
    *(uint4*)(KwTs + (tid >> 2) * 40 + (tid & 3) * 8) = rK0;
    *(uint4*)(KwTs + ((tid >> 2) + 64) * 40 + (tid & 3) * 8) = rK1;
    if (tid < 128) *(uint4*)(QKds + (tid >> 2) * 40 + (tid & 3) * 8) = rD;
    *(uint2*)(SbT + (fr) * 136 + (2 * wid + 0) * 16 + fq * 4) = make_uint2(pack2(S00[0], S00[1]), pack2(S00[2], S00[3]));
    *(uint2*)(SbT + (16 + fr) * 136 + (2 * wid + 0) * 16 + fq * 4) = make_uint2(pack2(S01[0], S01[1]), pack2(S01[2], S01[3]));
    *(uint2*)(SbT + (fr) * 136 + (2 * wid + 1) * 16 + fq * 4) = make_uint2(pack2(S10[0], S10[1]), pack2(S10[2], S10[3]));
    *(uint2*)(SbT + (16 + fr) * 136 + (2 * wid + 1) * 16 + fq * 4) = make_uint2(pack2(S11[0], S11[1]), pack2(S11[2], S11[3]));
    const float u0 = rU0, u1 = rU1, u2 = rU2, u3 = rU3, ac = rA;
    __syncthreads();
    if (ch + 1 < nch) DNS_PREFETCH(ch + 1)
    f32x4 accW = f32x4{0.f, 0.f, 0.f, 0.f}, accQ = f32x4{0.f, 0.f, 0.f, 0.f};
#pragma unroll
    for (int ks = 0; ks < 4; ks++) {
      const bf16x8 aw = *(const bf16x8*)(Wm + (mt * 16 + fr) * 136 + ks * 32 + fq * 8);
      const bf16x8 aq = *(const bf16x8*)(QAs + (mt * 16 + fr) * 136 + ks * 32 + fq * 8);
      const bf16x8 bs = *(const bf16x8*)(SbT + (nt * 16 + fr) * 136 + ks * 32 + fq * 8);
      accW = __builtin_amdgcn_mfma_f32_16x16x32_bf16(aw, bs, accW, 0, 0, 0);
      accQ = __builtin_amdgcn_mfma_f32_16x16x32_bf16(bs, aq, accQ, 0, 0, 0);
    }
    *(uint2*)(VnT + (nt * 16 + fr) * 40 + mt * 16 + fq * 4) =
        make_uint2(pack2(u0 - accW[0], u1 - accW[1]), pack2(u2 - accW[2], u3 - accW[3]));
    __syncthreads();
    {
      const bf16x8 a = *(const bf16x8*)(QKds + (mt * 16 + fr) * 40 + fq * 8);
      const bf16x8 b = *(const bf16x8*)(VnT + (nt * 16 + fr) * 40 + fq * 8);
      accQ = __builtin_amdgcn_mfma_f32_16x16x32_bf16(b, a, accQ, 0, 0, 0);
      {
        const int tok = tok_of(base, L, dir, ch * 32 + mt * 16 + fr);
        *(float4*)(obuf + (size_t)tok * 512 + hd * 128 + dvs * 32 + nt * 16 + fq * 4) = make_float4(accQ[0], accQ[1], accQ[2], accQ[3]);
      }
    }
    {
      const bf16x8 b0 = *(const bf16x8*)(VnT + (fr) * 40 + fq * 8);
      const bf16x8 b1 = *(const bf16x8*)(VnT + (16 + fr) * 40 + fq * 8);
      const bf16x8 a0 = *(const bf16x8*)(KwTs + ((2 * wid + 0) * 16 + fr) * 40 + fq * 8);
      const bf16x8 a1 = *(const bf16x8*)(KwTs + ((2 * wid + 1) * 16 + fr) * 40 + fq * 8);
      S00 *= ac; S01 *= ac; S10 *= ac; S11 *= ac;
      S00 = __builtin_amdgcn_mfma_f32_16x16x32_bf16(a0, b0, S00, 0, 0, 0);
      S01 = __builtin_amdgcn_mfma_f32_16x16x32_bf16(a0, b1, S01, 0, 0, 0);
      S10 = __builtin_amdgcn_mfma_f32_16x16x32_bf16(a1, b0, S10, 0, 0, 0);
      S11 = __builtin_amdgcn_mfma_f32_16x16x32_bf16(a1, b1, S11, 0, 0, 0);
    }
  }
#undef DNS_PREFETCH
  if (ctx) {
    float* st = p.out + O_DN + (((((size_t)seq * 4 + l) * 2 + dir) * 4 + hd) * 128) * 128 + dvs * 32 + fr;
#pragma unroll
    for (int j = 0; j < 4; j++) {
      st[(size_t)((2 * wid + 0) * 16 + fq * 4 + j) * 128] = S00[j];
      st[(size_t)((2 * wid + 0) * 16 + fq * 4 + j) * 128 + 16] = S01[j];
      st[(size_t)((2 * wid + 1) * 16 + fq * 4 + j) * 128] = S10[j];
      st[(size_t)((2 * wid + 1) * 16 + fq * 4 + j) * 128 + 16] = S11[j];
    }
  }
  __syncthreads();
}

__device__ void phase_dnpre(const P& p, char* smem) {
  for (int t = obid(); t < 1536; t += gridDim.x) dnpre_task(p, t, smem);
}

__device__ void phase_scan(const P& p, int l, char* smem) {
  __shared__ int s_task;
  for (;;) {
    if (otid() == 0) s_task = atomicAdd(&p.ctr[l], 1);
    __syncthreads();
    int t = __builtin_amdgcn_readfirstlane(s_task);
    __syncthreads();
    const int NX = 0;
    if (t >= 480) {
      if (t < 480 + NX) {
        t -= 480;
        convert_one(p, l + 1, t, smem);
        continue;
      }
      t -= NX;
      if (t >= 2016) break;
    }
    if (t < 32) {
      ssd_task(p, l, 16 + (t >> 4), (t >> 3) & 1, t & 7, smem);
    } else if (t < 288) {
      t -= 32;
      ssd_task(p, l, t >> 4, (t >> 3) & 1, t & 7, smem);
    } else if (t < 416) {
      t -= 288;
      s5_task(p, l, 16 + (t >> 6), (t >> 5) & 1, t & 31, smem);
    } else if (t < 480) {
      t -= 416;
      dnseq_task(p, l, 16 + (t >> 5), (t >> 4) & 1, (t >> 2) & 3, t & 3, smem);
    } else if (t < 1504) {
      t -= 480;
      s5_task(p, l, t >> 6, (t >> 5) & 1, t & 31, smem);
    } else {
      t -= 1504;
      dnseq_task(p, l, t >> 5, (t >> 4) & 1, (t >> 2) & 3, t & 3, smem);
    }
  }
}

__device__ void phase_post(const P& p, int l) {
  const int wid = otid() >> 6, lane = otid() & 63;
  for (int tok = obid() * 4 + wid; tok < NT; tok += gridDim.x * 4) {
    const float* pr = p.proj + (size_t)tok * INWP;
    const size_t o5 = (size_t)tok * 512;
#pragma unroll
    for (int i = 0; i < 2; i++) {
      const int c = lane * 4 + 256 * i;
      const float4 yf = *(const float4*)(p.s5y + o5 + c), yb = *(const float4*)(p.s5y + (size_t)NT * 512 + o5 + c);
      const float4 d = *(const float4*)(p.s5_d + l * 512 + c), u = *(const float4*)(pr + C_U + c);
      const float y0 = yf.x + yb.x + d.x * u.x, y1 = yf.y + yb.y + d.y * u.y, y2 = yf.z + yb.z + d.z * u.z, y3 = yf.w + yb.w + d.w * u.w;
      *(uint2*)(p.a_s5 + o5 + c) = make_uint2(pack2(gelu_tanh(y0), gelu_tanh(y1)), pack2(gelu_tanh(y2), gelu_tanh(y3)));
    }
    {
      float4 y[2];
      float ss = 0.f;
#pragma unroll
      for (int i = 0; i < 2; i++) {
        const int c = lane * 4 + 256 * i;
        const float4 yf = *(const float4*)(p.ssdy + o5 + c), yb = *(const float4*)(p.ssdy + (size_t)NT * 512 + o5 + c);
        const float4 xs = *(const float4*)(p.xbc + (size_t)tok * 768 + c), z = *(const float4*)(pr + C_Z + c);
        const float dd = p.ssd_d[l * 8 + (c >> 6)];
        y[i].x = (yf.x + yb.x + dd * xs.x) * siluf(z.x);
        y[i].y = (yf.y + yb.y + dd * xs.y) * siluf(z.y);
        y[i].z = (yf.z + yb.z + dd * xs.z) * siluf(z.z);
        y[i].w = (yf.w + yb.w + dd * xs.w) * siluf(z.w);
        ss += y[i].x * y[i].x + y[i].y * y[i].y + y[i].z * y[i].z + y[i].w * y[i].w;
      }
      ss = wave_sum(ss);
      const float r = rsqrtf(ss * (1.f / 512.f) + EPSF);
#pragma unroll
      for (int i = 0; i < 2; i++) {
        const int c = lane * 4 + 256 * i;
        const float4 gn = *(const float4*)(p.ssd_norm_g + l * 512 + c);
        *(uint2*)(p.a_ssd + o5 + c) = make_uint2(pack2(y[i].x * r * gn.x, y[i].y * r * gn.y), pack2(y[i].z * r * gn.z, y[i].w * r * gn.w));
      }
    }
#pragma unroll
    for (int i = 0; i < 2; i++) {
      const int c = lane * 4 + 256 * i;
      const float4 of = *(const float4*)(p.dny + o5 + c), ob = *(const float4*)(p.dny + (size_t)NT * 512 + o5 + c);
      const float o0 = of.x + ob.x, o1 = of.y + ob.y, o2 = of.z + ob.z, o3 = of.w + ob.w;
      const float ss = half_sum(o0 * o0 + o1 * o1 + o2 * o2 + o3 * o3);
      const float r = rsqrtf(ss * (1.f / 128.f) + EPSF);
      const float4 gn = *(const float4*)(p.dn_norm_g + l * 128 + (c & 127));
      const float4 gt = *(const float4*)(pr + C_DNG + c);
      *(uint2*)(p.a_dn + o5 + c) = make_uint2(pack2(o0 * r * gn.x * siluf(gt.x), o1 * r * gn.y * siluf(gt.y)),
                                              pack2(o2 * r * gn.z * siluf(gt.z), o3 * r * gn.w * siluf(gt.w)));
    }
  }
}

__global__ void __launch_bounds__(256, 2) fwd_megakernel(P p) {
  cg::grid_group grid = cg::this_grid();
  __shared__ __attribute__((aligned(16))) char smem[SMEM_BYTES];
  __shared__ uint4 xb_words;
  if (threadIdx.x == 0) xb_words = make_uint4(0u, 0u, 0u, 0u);
  __syncthreads();
  XcdBarrier xb = xcd_barrier_post(p.bar, (volatile LAS unsigned*)&xb_words);
  phase_init(p, smem);
  __syncthreads();
  for (int t = obid(); t < NCONV + 576; t += gridDim.x) {
    if (t < 576) ada_one(p, t / 144, t % 144, smem);
    else convert_one(p, 0, t - 576, smem);
  }
#define GSYNC() xcd_barrier(xb)
  if (p.out == nullptr) grid.sync();
  GSYNC();
  for (int l = 0; l < 4; l++) {
    const float* modl = p.mod + (size_t)l * 3 * 9216;
    const size_t wo = (size_t)(l & 1) * WT_SET;
    phase_normmod(p, l, 0); GSYNC();
    phase_swiglu(p, p.wt_wi + wo, smem); GSYNC();
    phase_resid(p, p.act, p.wt_wo + wo, DFF, modl + 2 * 1024, 0.5f, (l < 3) ? l + 1 : -1, 0, 700, smem); GSYNC();
    phase_normmod(p, l, 1); GSYNC();
    phase_proj(p, wo, smem); GSYNC();
    phase_prep(p, l); GSYNC();
    phase_dnpre(p, smem); GSYNC();
    phase_scan(p, l, smem); GSYNC();
    phase_post(p, l); GSYNC();
    phase_merge(p, wo, smem); GSYNC();
    phase_resid(p, p.h, p.wt_wout + wo, DM, modl + 5 * 1024, 1.0f, (l < 3) ? l + 1 : -1, 700, 950, smem); GSYNC();
    phase_normmod(p, l, 2); GSYNC();
    phase_swiglu(p, p.wt_wi + wo + (size_t)5632 * 1024, smem); GSYNC();
    phase_resid(p, p.act, p.wt_wo + wo + (size_t)1024 * 2816, DFF, modl + 8 * 1024, 0.5f, (l < 3) ? l + 1 : -1, 950, NCONV, smem); GSYNC();
  }
  phase_final(p);
}

extern "C" void kernel_launch(void* const* d_in, const int* in_sizes, int n_in, void* d_out, int out_size, void* d_ws,
                              size_t ws_size, hipStream_t stream) {
  static int grid_blocks = 0;
  if (!grid_blocks) {
    int dev = 0, cus = 0, per_cu = 0;
    hipGetDevice(&dev);
    hipDeviceGetAttribute(&cus, hipDeviceAttributeMultiprocessorCount, dev);
    hipOccupancyMaxActiveBlocksPerMultiprocessor(&per_cu, fwd_megakernel, 256, 0);
    if (per_cu > 2) per_cu = 2;
    if (per_cu < 1) per_cu = 1;
    grid_blocks = cus * per_cu;
  }
  P p{};
  const float** f = (const float**)&p;
  for (int i = 0; i < 37; i++) f[i] = (const float*)d_in[i];
  p.out = (float*)d_out;
  char* w = (char*)d_ws;
  size_t off = 0;
  auto take = [&](size_t bytes) { char* r = w + off; off += (bytes + 255) & ~(size_t)255; return r; };
  p.x = (float*)take((size_t)NT * DM * 4);
  p.mod = (float*)take((size_t)4 * 3 * 9216 * 4);
  p.lbr = (float*)take(16384 * 4);
  p.lbi = (float*)take(16384 * 4);
  p.bbr = (float*)take(16384 * 16 * 4);
  p.bbi = (float*)take(16384 * 16 * 4);
  p.proj = (float*)take((size_t)NT * INWP * 4);
  p.xbc = (float*)take((size_t)NT * 768 * 4);
  p.qkv = (float*)take((size_t)NT * 1536 * 4);
  p.dtv = (float*)take((size_t)NT * 16 * 4);
  p.dAv = (float*)take((size_t)NT * 16 * 4);
  p.betav = (float*)take((size_t)NT * 8 * 4);
  p.agv = (float*)take((size_t)NT * 8 * 4);
  p.qkd = (float*)take((size_t)NT * 4 * 4);
  p.s5y = (float*)take((size_t)2 * NT * 512 * 4);
  p.ssdy = (float*)take((size_t)2 * NT * 512 * 4);
  p.dny = (float*)take((size_t)2 * NT * 512 * 4);
  p.wt_wi = (bfraw*)take((size_t)2 * 5632 * 1024 * 2);
  p.wt_wo = (bfraw*)take((size_t)2 * 1024 * 2816 * 2);
  p.wt_win = (bfraw*)take((size_t)INWP * 1024 * 2);
  p.wt_glu = (bfraw*)take((size_t)2 * 1024 * 512 * 2);
  p.wt_ssdo = (bfraw*)take((size_t)1024 * 512 * 2);
  p.wt_dno = (bfraw*)take((size_t)1024 * 512 * 2);
  p.wt_wout = (bfraw*)take((size_t)1024 * 1024 * 2);
  (void)take(WT_SET * 2);
  p.h = (bfraw*)take((size_t)NT * DM * 2);
  p.act = (bfraw*)take((size_t)NT * DFF * 2);
  p.a_s5 = (bfraw*)take((size_t)NT * 512 * 2);
  p.a_ssd = (bfraw*)take((size_t)NT * 512 * 2);
  p.a_dn = (bfraw*)take((size_t)NT * 512 * 2);
  p.dn_u = (float*)take((size_t)1536 * 32 * 128 * 4);
  p.dn_ac = (float*)take((size_t)1536 * 4);
  p.dn_w = (bfraw*)take((size_t)1536 * 32 * 128 * 2);
  p.dn_qa = (bfraw*)take((size_t)1536 * 32 * 128 * 2);
  p.dn_kwt = (bfraw*)take((size_t)1536 * 128 * 32 * 2);
  p.dn_qkd = (bfraw*)take((size_t)1536 * 32 * 32 * 2);
  p.ssd_ac = (float*)take((size_t)NT * 16 * 4);
  p.ctr = (int*)take(256);
  p.bar = (unsigned*)take(XCD_BAR_WORDS * 4);
  hipMemsetAsync(p.bar, 0, XCD_BAR_WORDS * 4, stream);
  if (off > ws_size) fprintf(stderr, "workspace too small: need %zu have %zu\n", off, ws_size);
  void* args[] = {&p};
  hipError_t e = hipLaunchCooperativeKernel((void*)fwd_megakernel, dim3(grid_blocks), dim3(256), args, 0, stream);
  if (e != hipSuccess) fprintf(stderr, "cooperative launch failed: %s (grid %d)\n", hipGetErrorString(e), grid_blocks);
}
```

```cpp
#include <hip/hip_runtime.h>
#include <hip/hip_bf16.h>
#include <hip/hip_cooperative_groups.h>
#include <cstdio>
namespace cg = cooperative_groups;

typedef unsigned short bfraw;
using bf16x8 = __attribute__((ext_vector_type(8))) short;
using f32x4 = __attribute__((ext_vector_type(4))) float;

#define NT 6144
#define DM 1024
#define DFF 2816
#define INW 6944
#define INWP 7040
#define EPSF 1e-6f
#define SMEM_BYTES 73728
#define LDSK 72
#define WT_SET ((size_t)27656192)

#define C_U 0
#define C_Z 512
#define C_XBC 1024
#define C_DT 1792
#define C_QKV 1808
#define C_BETA 3344
#define C_AR 3352
#define C_DNG 3360
#define C_GATE 3872

#define O_S5R 6291456
#define O_S5I 6553600
#define O_SSD 6815744
#define O_DN 11010048

struct P {
  const float *x_prompt, *x_sample, *st_s5r, *st_s5i, *st_ssd, *st_dn, *c, *c_ctx, *ada_w, *ada_b, *norm_g, *ffn_wi, *ffn_wo, *w_in,
      *s5_lam_re, *s5_lam_im, *s5_log_dt, *s5_b_re, *s5_b_im, *s5_c_re, *s5_c_im, *s5_d, *s5_glu, *ssd_conv_w, *ssd_conv_b,
      *ssd_dt_bias, *ssd_a_log, *ssd_d, *ssd_norm_g, *ssd_w_out, *dn_conv_w, *dn_dt_bias, *dn_a_log, *dn_norm_g, *dn_w_out, *w_out,
      *final_norm_g;
  float* out;
  float *x, *mod, *lbr, *lbi, *bbr, *bbi, *proj, *xbc, *qkv, *dtv, *dAv, *betav, *agv, *qkd, *s5y, *ssdy, *dny;
  bfraw *wt_wi, *wt_wo, *wt_win, *wt_glu, *wt_ssdo, *wt_dno, *wt_wout, *h, *act, *a_s5, *a_ssd, *a_dn;
  int* ctr;
  unsigned* bar;
  float *dn_u, *dn_ac, *ssd_ac;
  bfraw *dn_w, *dn_qa, *dn_kwt, *dn_qkd;
};

typedef __attribute__((ext_vector_type(2))) float f32x2_t;
typedef __attribute__((ext_vector_type(2))) __bf16 bf16x2_t;
__device__ __forceinline__ bfraw f2bf(float f) {
  return __builtin_bit_cast(unsigned short, (__bf16)f);
}
__device__ __forceinline__ unsigned pack2(float a, float b) { f32x2_t v = {a, b}; return __builtin_bit_cast(unsigned, __builtin_convertvector(v, bf16x2_t)); }
__device__ __forceinline__ float siluf(float x) { return x * __builtin_amdgcn_rcpf(1.f + __expf(-x)); }
__device__ __forceinline__ float sigmf(float x) { return __builtin_amdgcn_rcpf(1.f + __expf(-x)); }
__device__ __forceinline__ float softplusf(float x) { return fmaxf(x, 0.f) + log1pf(__expf(-fabsf(x))); }
__device__ __forceinline__ float gelu_tanh(float x) {
  float t = 0.7978845608028654f * (x + 0.044715f * x * x * x);
  return 0.5f * x * (1.f + tanhf(t));
}
__device__ __forceinline__ float wave_sum(float v) {
#pragma unroll
  for (int o = 32; o >= 1; o >>= 1) v += __shfl_xor(v, o, 64);
  return v;
}
template <int CTRL>
__device__ __forceinline__ float dppf(float v) {
  return __builtin_bit_cast(float, __builtin_amdgcn_update_dpp(0, __builtin_bit_cast(int, v), CTRL, 0xF, 0xF, false));
}
__device__ __forceinline__ float red16(float v) {
  v += dppf<0xB1>(v);
  v += dppf<0x4E>(v);
  v += dppf<0x141>(v);
  v += dppf<0x140>(v);
  return v;
}
__device__ __forceinline__ int otid() { int t = threadIdx.x; asm volatile("" : "+v"(t)); return t; }
__device__ __forceinline__ int obid() { int t = blockIdx.x; asm volatile("" : "+s"(t)); return t; }
#define XB_TMO      128
#define XB_XCNT(j)  (256  + 64 * (j))
#define XB_XSUB(j)  (1280 + 64 * (j))
#define XB_XGEN(j)  (2304 + 64 * (j))
#define XB_TOP      3328
#define XB_TOPGEN   3392
#define XCD_BAR_WORDS 3456
#define XB_SPIN_CAP (1u << 18)
#define LAS __attribute__((address_space(3)))

__device__ __forceinline__ unsigned xb_ld(unsigned* p)              { return __hip_atomic_load(p, __ATOMIC_RELAXED, __HIP_MEMORY_SCOPE_AGENT); }
__device__ __forceinline__ unsigned xb_add(unsigned* p, unsigned v) { return __hip_atomic_fetch_add(p, v, __ATOMIC_RELAXED, __HIP_MEMORY_SCOPE_AGENT); }
__device__ __forceinline__ unsigned xb_xcc_id() { return (unsigned)__builtin_amdgcn_s_getreg((3 << 11) | 20) & 0xFu; }
#define XB_SPIN(cond, bar) do { unsigned _sp = 0; while (cond) { __builtin_amdgcn_s_sleep(1); \
    if ((++_sp & 255u) == 0u) { if (xb_ld(&(bar)[XB_TMO])) break; if (_sp > XB_SPIN_CAP) { atomicAdd(&(bar)[XB_TMO], 1u); break; } } } } while (0)

struct XcdBarrier {
    unsigned* bar; unsigned x;
    volatile LAS unsigned* st;
};

__device__ __forceinline__ XcdBarrier xcd_barrier_post(unsigned* bar, volatile LAS unsigned* st) {
    XcdBarrier b; b.bar = bar; b.x = xb_xcc_id(); b.st = st;
    if (threadIdx.x == 0) (void)xb_add(&bar[XB_XCNT(b.x)], 1u);
    return b;
}
__device__ __forceinline__ void xcd_barrier_complete(unsigned* bar, unsigned x, unsigned& nloc, unsigned& nx) {
    const unsigned G = gridDim.x * gridDim.y * gridDim.z;
    unsigned sum, cnt, mine, sp = 0u;
    for (;;) {
        sum = 0u; cnt = 0u; mine = 0u;
#pragma unroll
        for (unsigned j = 0; j < 16; ++j) { const unsigned c = xb_ld(&bar[XB_XCNT(j)]); sum += c; cnt += (c > 0u) ? 1u : 0u; mine = (j == x) ? c : mine; }
        if (sum == G) break;
        __builtin_amdgcn_s_sleep(1);
        if ((++sp & 255u) == 0u) { if (xb_ld(&bar[XB_TMO])) break; if (sp > XB_SPIN_CAP) { atomicAdd(&bar[XB_TMO], 1u); break; } }
    }
    nloc = mine > 0u ? mine : 1u; nx = cnt > 0u ? cnt : 1u;
}

__device__ __forceinline__ void xcd_barrier(const XcdBarrier& b) {
    asm volatile("s_waitcnt vmcnt(0)" ::: "memory");
    __syncthreads();
    if (threadIdx.x == 0) {
        unsigned* bar = b.bar;
        __builtin_amdgcn_s_waitcnt(0);
        unsigned nloc = b.st[0], nx = b.st[1];
        if (nloc == 0u) { xcd_barrier_complete(bar, b.x, nloc, nx); b.st[0] = nloc; b.st[1] = nx; }
        const unsigned old = xb_add(&bar[XB_XSUB(b.x)], 1u);
        const unsigned gen = old / nloc;
        if (old + 1u == (gen + 1u) * nloc) {
            __builtin_amdgcn_fence(__ATOMIC_RELEASE, "agent");
            asm volatile("s_waitcnt vmcnt(0)" ::: "memory");
            const unsigned og = xb_add(&bar[XB_TOP], 1u);
            const unsigned tg = og / nx;
            if (og + 1u == (tg + 1u) * nx) xb_add(&bar[XB_TOPGEN], 1u);
            else XB_SPIN(xb_ld(&bar[XB_TOPGEN]) == tg, bar);
            __builtin_amdgcn_fence(__ATOMIC_ACQUIRE, "agent");
            xb_add(&bar[XB_XGEN(b.x)], 1u);
            asm volatile("s_waitcnt vmcnt(0)" ::: "memory");
        } else {
            XB_SPIN(xb_ld(&bar[XB_XGEN(b.x)]) == gen, bar);
            __builtin_amdgcn_fence(__ATOMIC_ACQUIRE, "agent");
            asm volatile("s_waitcnt vmcnt(0)" ::: "memory");
        }
    }
    __syncthreads();
}


__device__ __forceinline__ int cond_of(int row) { return row < 4096 ? 0 : 1 + ((row - 4096) >> 10); }

template <int NSUB, bool PAIRED, int MSUB = 4>
__device__ __forceinline__ void gemm_tile(const bfraw* __restrict__ A, int lda, const bfraw* __restrict__ Bt, int ldb, int K,
                                          int row0, int brow0, bfraw* sA, bfraw* sB, f32x4 (&acc)[MSUB][NSUB]) {
  constexpr int BN = NSUB * 32;
  const int tid = otid(), wid = tid >> 6, lane = tid & 63, wr = wid >> 1, wc = wid & 1, fr = lane & 15, fq = lane >> 4;
  uint4 ra0, ra1, ra2, ra3, rb0, rb1, rb2, rb3;
  const int cr = tid >> 3, cc = tid & 7;
  const bfraw* ga = A + (size_t)(row0 + cr) * lda + cc * 8;
  const bfraw* gb = Bt + (size_t)(brow0 + cr) * ldb + cc * 8;
  const int nk = K >> 6;
  rb2 = make_uint4(0, 0, 0, 0); rb3 = rb2; ra3 = rb2;
#define GLOAD(KO)                                               \
  ra0 = *(const uint4*)(ga + (size_t)(0) * lda + (KO));         \
  ra1 = *(const uint4*)(ga + (size_t)(32) * lda + (KO));        \
  ra2 = *(const uint4*)(ga + (size_t)(64) * lda + (KO));        \
  if (MSUB == 4) ra3 = *(const uint4*)(ga + (size_t)(96) * lda + (KO)); \
  rb0 = *(const uint4*)(gb + (size_t)(0) * ldb + (KO));         \
  rb1 = *(const uint4*)(gb + (size_t)(32) * ldb + (KO));        \
  if (NSUB == 4) {                                              \
    rb2 = *(const uint4*)(gb + (size_t)(64) * ldb + (KO));      \
    rb3 = *(const uint4*)(gb + (size_t)(96) * ldb + (KO));      \
  }
  GLOAD(0)
  int bcol[NSUB];
#pragma unroll
  for (int n = 0; n < NSUB; n++) bcol[n] = PAIRED ? ((n >> 1) * 64 + wc * 32 + (n & 1) * 16) : (wc * (NSUB * 16) + n * 16);
  for (int kt = 0; kt < nk; kt++) {
    const int buf = kt & 1;
    bfraw* a_s = sA + buf * (128 * LDSK);
    bfraw* b_s = sB + buf * (BN * LDSK);
    *(uint4*)(a_s + (cr + 0) * LDSK + cc * 8) = ra0;
    *(uint4*)(a_s + (cr + 32) * LDSK + cc * 8) = ra1;
    *(uint4*)(a_s + (cr + 64) * LDSK + cc * 8) = ra2;
    if (MSUB == 4) *(uint4*)(a_s + (cr + 96) * LDSK + cc * 8) = ra3;
    *(uint4*)(b_s + (cr + 0) * LDSK + cc * 8) = rb0;
    *(uint4*)(b_s + (cr + 32) * LDSK + cc * 8) = rb1;
    if (NSUB == 4) {
      *(uint4*)(b_s + (cr + 64) * LDSK + cc * 8) = rb2;
      *(uint4*)(b_s + (cr + 96) * LDSK + cc * 8) = rb3;
    }
    __syncthreads();
    if (kt + 1 < nk) { GLOAD((kt + 1) * 64) }
    __builtin_amdgcn_sched_barrier(0);
#pragma unroll
    for (int ks = 0; ks < 2; ks++) {
      bf16x8 af[MSUB], bfv[NSUB];
#pragma unroll
      for (int m = 0; m < MSUB; m++) af[m] = *(const bf16x8*)(a_s + (wr * (MSUB * 16) + m * 16 + fr) * LDSK + ks * 32 + fq * 8);
#pragma unroll
      for (int n = 0; n < NSUB; n++) bfv[n] = *(const bf16x8*)(b_s + (bcol[n] + fr) * LDSK + ks * 32 + fq * 8);
      __builtin_amdgcn_s_setprio(1);
#pragma unroll
      for (int m = 0; m < MSUB; m++)
#pragma unroll
        for (int n = 0; n < NSUB; n++) acc[m][n] = __builtin_amdgcn_mfma_f32_16x16x32_bf16(bfv[n], af[m], acc[m][n], 0, 0, 0);
      __builtin_amdgcn_s_setprio(0);
    }
  }
  __syncthreads();
#undef GLOAD
}

#define GEMM_IDS                                                                                              \
  const int tid = otid(), wid = tid >> 6, lane = tid & 63, wr = wid >> 1, wc = wid & 1, fr = lane & 15, \
            fq = lane >> 4;                                                                                   \
  bfraw* sA = (bfraw*)smem;                                                                                   \
  bfraw* sB = sA + 2 * 128 * LDSK;                                                                            \
  (void)tid; (void)wid; (void)lane; (void)wr; (void)wc; (void)fr; (void)fq;

__device__ void convert_one(const P& p, int l, int t, char* smem);
__device__ void phase_swiglu(const P& p, const bfraw* Wt, char* smem) {
  GEMM_IDS
  for (int tile = obid(); tile < 48 * 44; tile += gridDim.x) {
    const int mt = tile % 48, nt = tile / 48;
    f32x4 acc[4][4];
#pragma unroll
    for (int m = 0; m < 4; m++)
#pragma unroll
      for (int n = 0; n < 4; n++) acc[m][n] = f32x4{0.f, 0.f, 0.f, 0.f};
    gemm_tile<4, true>(p.h, DM, Wt, DM, DM, mt * 128, nt * 128, sA, sB, acc);
#pragma unroll
    for (int m = 0; m < 4; m++)
#pragma unroll
      for (int n = 0; n < 2; n++) {
        const int row = mt * 128 + wr * 64 + m * 16 + fr;
        const int col = nt * 64 + wc * 32 + n * 16 + fq * 4;
        const f32x4 a = acc[m][n], b = acc[m][n + 2];
        *(uint2*)(p.act + (size_t)row * DFF + col) =
            make_uint2(pack2(siluf(a[0]) * b[0], siluf(a[1]) * b[1]), pack2(siluf(a[2]) * b[2], siluf(a[3]) * b[3]));
      }
  }
}

__device__ void phase_resid(const P& p, const bfraw* A, const bfraw* Wt, int K, const float* gate  ,
                            float scale, int cl  , int cbeg, int cend, char* smem) {
  GEMM_IDS
  if (cl >= 0) {
    if (gridDim.x > 384) {
      if (obid() >= 384) {
        for (int t = cbeg + (obid() - 384); t < cend; t += (gridDim.x - 384)) convert_one(p, cl, t, smem);
        return;
      }
    } else {
      for (int t = cbeg + obid(); t < cend; t += gridDim.x) convert_one(p, cl, t, smem);
    }
  }
  for (int tile = obid(); tile < 48 * 8; tile += gridDim.x) {
    const int mt = tile % 48, nt = tile / 48;
    f32x4 acc[4][4];
#pragma unroll
    for (int m = 0; m < 4; m++)
#pragma unroll
      for (int n = 0; n < 4; n++) acc[m][n] = f32x4{0.f, 0.f, 0.f, 0.f};
    gemm_tile<4, false>(A, K, Wt, K, K, mt * 128, nt * 128, sA, sB, acc);
#pragma unroll
    for (int m = 0; m < 4; m++)
#pragma unroll
      for (int n = 0; n < 4; n++) {
        const int row = mt * 128 + wr * 64 + m * 16 + fr;
        const int col = nt * 128 + wc * 64 + n * 16 + fq * 4;
        const float4 g = *(const float4*)(gate + cond_of(row) * 9216 + col);
        float4* xp = (float4*)(p.x + (size_t)row * DM + col);
        float4 xv = *xp;
        xv.x += scale * g.x * acc[m][n][0];
        xv.y += scale * g.y * acc[m][n][1];
        xv.z += scale * g.z * acc[m][n][2];
        xv.w += scale * g.w * acc[m][n][3];
        *xp = xv;
      }
  }
}

__device__ void phase_proj(const P& p, size_t wo, char* smem) {
  GEMM_IDS
  for (int tile = obid(); tile < 48 * 55; tile += gridDim.x) {
    const int mt = tile % 48, nt = tile / 48;
    f32x4 acc[4][4];
#pragma unroll
    for (int m = 0; m < 4; m++)
#pragma unroll
      for (int n = 0; n < 4; n++) acc[m][n] = f32x4{0.f, 0.f, 0.f, 0.f};
    gemm_tile<4, false>(p.h, DM, p.wt_win + wo, DM, DM, mt * 128, nt * 128, sA, sB, acc);
#pragma unroll
    for (int m = 0; m < 4; m++)
#pragma unroll
      for (int n = 0; n < 4; n++) {
        const int row = mt * 128 + wr * 64 + m * 16 + fr;
        const int col = nt * 128 + wc * 64 + n * 16 + fq * 4;
        *(float4*)(p.proj + (size_t)row * INWP + col) = make_float4(acc[m][n][0], acc[m][n][1], acc[m][n][2], acc[m][n][3]);
      }
  }
}

__device__ void phase_merge(const P& p, size_t wo, char* smem) {
  GEMM_IDS
  for (int tile = obid(); tile < 64 * 16; tile += gridDim.x) {
    const int mt = tile & 63, nt = tile >> 6;
    f32x4 acc[3][2], acc2[3][2], mg[3][2];
#pragma unroll
    for (int m = 0; m < 3; m++)
#pragma unroll
      for (int n = 0; n < 2; n++) { acc[m][n] = f32x4{0.f, 0.f, 0.f, 0.f}; acc2[m][n] = f32x4{0.f, 0.f, 0.f, 0.f}; }
    gemm_tile<2, false, 3>(p.a_s5, 512, p.wt_glu + wo, 512, 512, mt * 96, nt * 64, sA, sB, acc);
    gemm_tile<2, false, 3>(p.a_s5, 512, p.wt_glu + wo + 1024 * 512, 512, 512, mt * 96, nt * 64, sA, sB, acc2);
#pragma unroll
    for (int m = 0; m < 3; m++)
#pragma unroll
      for (int n = 0; n < 2; n++) {
        const int row = mt * 96 + wr * 48 + m * 16 + fr;
        const int col = nt * 64 + wc * 32 + n * 16 + fq * 4;
        const float4 g = *(const float4*)(p.proj + (size_t)row * INWP + C_GATE + col);
        mg[m][n][0] = sigmf(g.x) * acc[m][n][0] * sigmf(acc2[m][n][0]);
        mg[m][n][1] = sigmf(g.y) * acc[m][n][1] * sigmf(acc2[m][n][1]);
        mg[m][n][2] = sigmf(g.z) * acc[m][n][2] * sigmf(acc2[m][n][2]);
        mg[m][n][3] = sigmf(g.w) * acc[m][n][3] * sigmf(acc2[m][n][3]);
        acc[m][n] = f32x4{0.f, 0.f, 0.f, 0.f};
      }
    gemm_tile<2, false, 3>(p.a_ssd, 512, p.wt_ssdo + wo, 512, 512, mt * 96, nt * 64, sA, sB, acc);
#pragma unroll
    for (int m = 0; m < 3; m++)
#pragma unroll
      for (int n = 0; n < 2; n++) {
        const int row = mt * 96 + wr * 48 + m * 16 + fr;
        const int col = nt * 64 + wc * 32 + n * 16 + fq * 4;
        const float4 g = *(const float4*)(p.proj + (size_t)row * INWP + C_GATE + 1024 + col);
        mg[m][n][0] += sigmf(g.x) * acc[m][n][0];
        mg[m][n][1] += sigmf(g.y) * acc[m][n][1];
        mg[m][n][2] += sigmf(g.z) * acc[m][n][2];
        mg[m][n][3] += sigmf(g.w) * acc[m][n][3];
        acc[m][n] = f32x4{0.f, 0.f, 0.f, 0.f};
      }
    gemm_tile<2, false, 3>(p.a_dn, 512, p.wt_dno + wo, 512, 512, mt * 96, nt * 64, sA, sB, acc);
#pragma unroll
    for (int m = 0; m < 3; m++)
#pragma unroll
      for (int n = 0; n < 2; n++) {
        const int row = mt * 96 + wr * 48 + m * 16 + fr;
        const int col = nt * 64 + wc * 32 + n * 16 + fq * 4;
        const float4 g = *(const float4*)(p.proj + (size_t)row * INWP + C_GATE + 2048 + col);
        *(uint2*)(p.h + (size_t)row * DM + col) =
            make_uint2(pack2(mg[m][n][0] + sigmf(g.x) * acc[m][n][0], mg[m][n][1] + sigmf(g.y) * acc[m][n][1]),
                       pack2(mg[m][n][2] + sigmf(g.z) * acc[m][n][2], mg[m][n][3] + sigmf(g.w) * acc[m][n][3]));
      }
  }
}

__device__ void conv_tile(const float* __restrict__ src, int K, int Nsrc, bfraw* __restrict__ dst, int kt, int nt, int scol0,
                          float* tile  ) {
  const int tid = otid();
  {
    const int r = tid >> 4, c4 = tid & 15;
#pragma unroll
    for (int rr = 0; rr < 4; rr++) {
      const int k = rr * 16 + r;
      float4 v = make_float4(0.f, 0.f, 0.f, 0.f);
      if (scol0 + c4 * 4 + 3 < Nsrc) v = *(const float4*)(src + (size_t)(kt * 64 + k) * Nsrc + scol0 + c4 * 4);
      tile[k * 65 + c4 * 4 + 0] = v.x;
      tile[k * 65 + c4 * 4 + 1] = v.y;
      tile[k * 65 + c4 * 4 + 2] = v.z;
      tile[k * 65 + c4 * 4 + 3] = v.w;
    }
  }
  __syncthreads();
  {
    const int n = tid >> 2, kq = tid & 3;
    unsigned w[8];
#pragma unroll
    for (int e = 0; e < 8; e++) {
      const float a = tile[(kq * 16 + 2 * e) * 65 + n], b = tile[(kq * 16 + 2 * e + 1) * 65 + n];
      w[e] = (unsigned)f2bf(a) | ((unsigned)f2bf(b) << 16);
    }
    bfraw* d = dst + (size_t)(nt * 64 + n) * K + kt * 64 + kq * 16;
    *(uint4*)(d) = make_uint4(w[0], w[1], w[2], w[3]);
    *(uint4*)(d + 8) = make_uint4(w[4], w[5], w[6], w[7]);
  }
  __syncthreads();
}

__device__ void conv_tile4(const float* __restrict__ src, int K, int Nsrc, bfraw* __restrict__ dst, int kt, int nt0, int ntiles,
                           bool paired, float* tile  ) {
  const int tid = otid();
  const int r = tid >> 4, c4 = tid & 15;
  float4 v[4][4];
#pragma unroll
  for (int q = 0; q < 4; q++) {
    const int nt = nt0 + q;
    const int scol0 = paired ? ((nt & 1) * 2816 + (nt >> 1) * 64) : nt * 64;
    const bool ok = (nt < ntiles) && (scol0 + c4 * 4 + 3 < Nsrc);
#pragma unroll
    for (int rr = 0; rr < 4; rr++) {
      v[q][rr] = make_float4(0.f, 0.f, 0.f, 0.f);
      if (ok) v[q][rr] = *(const float4*)(src + (size_t)(kt * 64 + rr * 16 + r) * Nsrc + scol0 + c4 * 4);
    }
  }
#pragma unroll
  for (int q = 0; q < 4; q++) {
    const int nt = nt0 + q;
    if (nt < ntiles) {
#pragma unroll
      for (int rr = 0; rr < 4; rr++) {
        const int k = rr * 16 + r;
        tile[k * 65 + c4 * 4 + 0] = v[q][rr].x;
        tile[k * 65 + c4 * 4 + 1] = v[q][rr].y;
        tile[k * 65 + c4 * 4 + 2] = v[q][rr].z;
        tile[k * 65 + c4 * 4 + 3] = v[q][rr].w;
      }
      __syncthreads();
      {
        const int n = tid >> 2, kq = tid & 3;
        unsigned w[8];
#pragma unroll
        for (int e = 0; e < 8; e++) {
          const float x0 = tile[(kq * 16 + 2 * e) * 65 + n], x1 = tile[(kq * 16 + 2 * e + 1) * 65 + n];
          w[e] = (unsigned)f2bf(x0) | ((unsigned)f2bf(x1) << 16);
        }
        bfraw* d = dst + (size_t)(nt * 64 + n) * K + kt * 64 + kq * 16;
        *(uint4*)(d) = make_uint4(w[0], w[1], w[2], w[3]);
        *(uint4*)(d + 8) = make_uint4(w[4], w[5], w[6], w[7]);
      }
      __syncthreads();
    }
  }
}

#define NCONV 1696
__device__ void convert_one(const P& p, int l, int t, char* smem) {
  float* tile = (float*)smem;
  const size_t wo = (size_t)(l & 1) * WT_SET;
  int u = t;
  if (u < 704) {
    const int s = u / 352; u -= s * 352;
    const int kt = u & 15, nq = u >> 4;
    conv_tile4(p.ffn_wi + (size_t)(l * 2 + s) * 1024 * 5632, 1024, 5632, p.wt_wi + wo + (size_t)s * 5632 * 1024, kt, nq * 4, 88, true, tile);
  } else if (u < 1056) {
    u -= 704;
    const int s = u / 176; u -= s * 176;
    const int kt = u % 44, nq = u / 44;
    conv_tile4(p.ffn_wo + (size_t)(l * 2 + s) * 2816 * 1024, 2816, 1024, p.wt_wo + wo + (size_t)s * 1024 * 2816, kt, nq * 4, 16, false, tile);
  } else if (u < 1504) {
    u -= 1056;
    const int kt = u & 15, nq = u >> 4;
    conv_tile4(p.w_in + (size_t)l * 1024 * 6944, 1024, 6944, p.wt_win + wo, kt, nq * 4, 110, false, tile);
  } else if (u < 1568) {
    u -= 1504;
    const int s = u >> 5; u &= 31;
    const int kt = u & 7, nq = u >> 3;
    conv_tile4(p.s5_glu + (size_t)(l * 2 + s) * 512 * 1024, 512, 1024, p.wt_glu + wo + (size_t)s * 1024 * 512, kt, nq * 4, 16, false, tile);
  } else if (u < 1600) {
    u -= 1568;
    const int kt = u & 7, nq = u >> 3;
    conv_tile4(p.ssd_w_out + (size_t)l * 512 * 1024, 512, 1024, p.wt_ssdo + wo, kt, nq * 4, 16, false, tile);
  } else if (u < 1632) {
    u -= 1600;
    const int kt = u & 7, nq = u >> 3;
    conv_tile4(p.dn_w_out + (size_t)l * 512 * 1024, 512, 1024, p.wt_dno + wo, kt, nq * 4, 16, false, tile);
  } else {
    u -= 1632;
    const int kt = u & 15, nq = u >> 4;
    conv_tile4(p.w_out + (size_t)l * 1024 * 1024, 1024, 1024, p.wt_wout + wo, kt, nq * 4, 16, false, tile);
  }
}

__device__ void phase_init(const P& p, char* smem) {
  const int tid = otid(), wid = tid >> 6, lane = tid & 63;
  const int gtid = obid() * 256 + tid, gsz = gridDim.x * 256;
  if (gtid < 8) p.ctr[gtid] = 0;
  for (int i = gtid; i < NT * DM / 4; i += gsz) {
    float4 v = (i < 4096 * 256) ? ((const float4*)p.x_prompt)[i] : ((const float4*)p.x_sample)[i - 4096 * 256];
    ((float4*)p.x)[i] = v;
  }
  for (int i = gtid; i < 4 * 2 * 32 * 64; i += gsz) {
    const int ldg = i >> 6;
    const float dt = __expf(p.s5_log_dt[ldg]);
    const float lr = p.s5_lam_re[i], li = p.s5_lam_im[i];
    const float mag = expf(lr * dt);
    const float br = mag * cosf(li * dt), bi = mag * sinf(li * dt);
    const float den = lr * lr + li * li;
    const float cr = ((br - 1.f) * lr + bi * li) / den;
    const float ci = (bi * lr - (br - 1.f) * li) / den;
    p.lbr[i] = br;
    p.lbi[i] = bi;
#pragma unroll
    for (int k = 0; k < 16; k++) {
      const float b_re = p.s5_b_re[(size_t)i * 16 + k], b_im = p.s5_b_im[(size_t)i * 16 + k];
      p.bbr[(size_t)i * 16 + k] = cr * b_re - ci * b_im;
      p.bbi[(size_t)i * 16 + k] = cr * b_im + ci * b_re;
    }
  }
}

__device__ void ada_one(const P& p, int l, int cb, char* smem) {
  const int tid = otid(), lane = tid & 63;
  float* sc = (float*)smem;
  float* red = sc + 3 * 1024;
  for (int i = tid; i < 3 * 1024; i += 256) {
    const int c = i >> 10, k = i & 1023;
    const float v = (c == 0) ? p.c_ctx[k] : p.c[(c - 1) * 1024 + k];
    sc[i] = siluf(v);
  }
  __syncthreads();
  {
    const int kg = tid >> 4, c4 = tid & 15;
    const float* w = p.ada_w + (size_t)l * 1024 * 9216 + cb * 64 + c4 * 4 + (size_t)(kg * 64) * 9216;
    float4 a0 = make_float4(0.f, 0.f, 0.f, 0.f), a1 = a0, a2 = a0;
#pragma unroll 16
    for (int kk = 0; kk < 64; kk++) {
      const float4 wv = *(const float4*)(w + (size_t)kk * 9216);
      const int k = kg * 64 + kk;
      const float s0 = sc[k], s1 = sc[1024 + k], s2 = sc[2048 + k];
      a0.x += s0 * wv.x; a0.y += s0 * wv.y; a0.z += s0 * wv.z; a0.w += s0 * wv.w;
      a1.x += s1 * wv.x; a1.y += s1 * wv.y; a1.z += s1 * wv.z; a1.w += s1 * wv.w;
      a2.x += s2 * wv.x; a2.y += s2 * wv.y; a2.z += s2 * wv.z; a2.w += s2 * wv.w;
    }
    *(float4*)(red + (kg * 3 + 0) * 64 + c4 * 4) = a0;
    *(float4*)(red + (kg * 3 + 1) * 64 + c4 * 4) = a1;
    *(float4*)(red + (kg * 3 + 2) * 64 + c4 * 4) = a2;
    __syncthreads();
    if (tid < 192) {
      const int c = tid >> 6;
      float sacc = 0.f;
#pragma unroll
      for (int g = 0; g < 16; g++) sacc += red[(g * 3 + c) * 64 + lane];
      p.mod[(size_t)(l * 3 + c) * 9216 + cb * 64 + lane] = sacc + p.ada_b[(size_t)l * 9216 + cb * 64 + lane];
    }
    __syncthreads();
  }
}

__device__ void phase_normmod(const P& p, int l, int sub) {
  const int wid = otid() >> 6, lane = otid() & 63;
  const float* g = p.norm_g + (size_t)(l * 3 + sub) * 1024;
  for (int tok = obid() * 4 + wid; tok < NT; tok += gridDim.x * 4) {
    const float* xr = p.x + (size_t)tok * DM;
    float4 v[4];
    float ss = 0.f;
#pragma unroll
    for (int i = 0; i < 4; i++) {
      v[i] = *(const float4*)(xr + lane * 4 + i * 256);
      ss += v[i].x * v[i].x + v[i].y * v[i].y + v[i].z * v[i].z + v[i].w * v[i].w;
    }
    ss = wave_sum(ss);
    const float r = rsqrtf(ss * (1.f / 1024.f) + EPSF);
    const float* md = p.mod + (size_t)(l * 3 + cond_of(tok)) * 9216 + sub * 3 * 1024;
#pragma unroll
    for (int i = 0; i < 4; i++) {
      const int c = lane * 4 + i * 256;
      const float4 gg = *(const float4*)(g + c);
      const float4 sh = *(const float4*)(md + c);
      const float4 scv = *(const float4*)(md + 1024 + c);
      const float o0 = v[i].x * r * gg.x * (1.f + scv.x) + sh.x;
      const float o1 = v[i].y * r * gg.y * (1.f + scv.y) + sh.y;
      const float o2 = v[i].z * r * gg.z * (1.f + scv.z) + sh.z;
      const float o3 = v[i].w * r * gg.w * (1.f + scv.w) + sh.w;
      uint2 o;
      o.x = (unsigned)f2bf(o0) | ((unsigned)f2bf(o1) << 16);
      o.y = (unsigned)f2bf(o2) | ((unsigned)f2bf(o3) << 16);
      *(uint2*)(p.h + (size_t)tok * DM + c) = o;
    }
  }
}

__device__ void phase_final(const P& p) {
  const int wid = otid() >> 6, lane = otid() & 63;
  for (int tok = obid() * 4 + wid; tok < NT; tok += gridDim.x * 4) {
    const float* xr = p.x + (size_t)tok * DM;
    float4 v[4];
    float ss = 0.f;
#pragma unroll
    for (int i = 0; i < 4; i++) {
      v[i] = *(const float4*)(xr + lane * 4 + i * 256);
      ss += v[i].x * v[i].x + v[i].y * v[i].y + v[i].z * v[i].z + v[i].w * v[i].w;
    }
    ss = wave_sum(ss);
    const float r = rsqrtf(ss * (1.f / 1024.f) + EPSF);
#pragma unroll
    for (int i = 0; i < 4; i++) {
      const int c = lane * 4 + i * 256;
      const float4 gg = *(const float4*)(p.final_norm_g + c);
      float4 o = make_float4(v[i].x * r * gg.x, v[i].y * r * gg.y, v[i].z * r * gg.z, v[i].w * r * gg.w);
      *(float4*)(p.out + (size_t)tok * DM + c) = o;
    }
  }
}

__device__ __forceinline__ float half_sum(float v) {
#pragma unroll
  for (int o = 16; o >= 1; o >>= 1) v += __shfl_xor(v, o, 64);
  return v;
}
__device__ __forceinline__ float4 conv3(const float4 w0, const float4 w1, const float4 w2, const float4 xm, const float4 x0,
                                        const float4 xp, float fp, float fn) {
  float4 r;
  r.x = w0.x * fp * xm.x + w1.x * x0.x + w2.x * fn * xp.x;
  r.y = w0.y * fp * xm.y + w1.y * x0.y + w2.y * fn * xp.y;
  r.z = w0.z * fp * xm.z + w1.z * x0.z + w2.z * fn * xp.z;
  r.w = w0.w * fp * xm.w + w1.w * x0.w + w2.w * fn * xp.w;
  return r;
}
__device__ void phase_prep(const P& p, int l) {
  const int wid = otid() >> 6, lane = otid() & 63;
  const float* cw = p.ssd_conv_w + (size_t)l * 3 * 768;
  const float* cb = p.ssd_conv_b + (size_t)l * 768;
  const float* dw = p.dn_conv_w + (size_t)l * 3 * 1536;
  for (int tok = obid() * 4 + wid; tok < NT; tok += gridDim.x * 4) {
    bool hp, hn;
    if (tok < 4096) { const int t = tok & 255; hp = t > 0; hn = t < 255; }
    else { const int w = (tok - 4096) & 63; hp = w > 0; hn = w < 63; }
    const float* pr = p.proj + (size_t)tok * INWP;
    const float* pm = hp ? pr - INWP : pr;
    const float* pn = hn ? pr + INWP : pr;
    const float fp = hp ? 1.f : 0.f, fn = hn ? 1.f : 0.f;
#pragma unroll
    for (int i = 0; i < 3; i++) {
      const int c = lane * 4 + 256 * i;
      float4 v = conv3(*(const float4*)(cw + c), *(const float4*)(cw + 768 + c), *(const float4*)(cw + 1536 + c),
                       *(const float4*)(pm + C_XBC + c), *(const float4*)(pr + C_XBC + c), *(const float4*)(pn + C_XBC + c), fp, fn);
      const float4 bb = *(const float4*)(cb + c);
      v.x = siluf(v.x + bb.x); v.y = siluf(v.y + bb.y); v.z = siluf(v.z + bb.z); v.w = siluf(v.w + bb.w);
      *(float4*)(p.xbc + (size_t)tok * 768 + c) = v;
    }
#pragma unroll
    for (int hpair = 0; hpair < 2; hpair++) {
      const int hh = hpair * 2 + (lane >> 5);
      const int cq = hh * 128 + (lane & 31) * 4, ck = 512 + cq, cv = 1024 + cq;
      float4 q = conv3(*(const float4*)(dw + cq), *(const float4*)(dw + 1536 + cq), *(const float4*)(dw + 3072 + cq),
                       *(const float4*)(pm + C_QKV + cq), *(const float4*)(pr + C_QKV + cq), *(const float4*)(pn + C_QKV + cq), fp, fn);
      float4 k = conv3(*(const float4*)(dw + ck), *(const float4*)(dw + 1536 + ck), *(const float4*)(dw + 3072 + ck),
                       *(const float4*)(pm + C_QKV + ck), *(const float4*)(pr + C_QKV + ck), *(const float4*)(pn + C_QKV + ck), fp, fn);
      float4 v = conv3(*(const float4*)(dw + cv), *(const float4*)(dw + 1536 + cv), *(const float4*)(dw + 3072 + cv),
                       *(const float4*)(pm + C_QKV + cv), *(const float4*)(pr + C_QKV + cv), *(const float4*)(pn + C_QKV + cv), fp, fn);
      q.x = siluf(q.x); q.y = siluf(q.y); q.z = siluf(q.z); q.w = siluf(q.w);
      k.x = siluf(k.x); k.y = siluf(k.y); k.z = siluf(k.z); k.w = siluf(k.w);
      v.x = siluf(v.x); v.y = siluf(v.y); v.z = siluf(v.z); v.w = siluf(v.w);
      const float sq = half_sum(q.x * q.x + q.y * q.y + q.z * q.z + q.w * q.w);
      const float sk = half_sum(k.x * k.x + k.y * k.y + k.z * k.z + k.w * k.w);
      const float rq = rsqrtf(sq + EPSF) * 0.08838834764831845f;
      const float rk = rsqrtf(sk + EPSF);
      *(float4*)(p.qkv + (size_t)tok * 1536 + cq) = make_float4(q.x * rq, q.y * rq, q.z * rq, q.w * rq);
      *(float4*)(p.qkv + (size_t)tok * 1536 + ck) = make_float4(k.x * rk, k.y * rk, k.z * rk, k.w * rk);
      *(float4*)(p.qkv + (size_t)tok * 1536 + cv) = v;
    }
    if (lane < 16) {
      const float dt = softplusf(pr[C_DT + lane] + p.ssd_dt_bias[l * 16 + lane]);
      const float a = -__expf(p.ssd_a_log[l * 16 + lane]);
      p.dtv[tok * 16 + lane] = dt;
      p.dAv[tok * 16 + lane] = dt * a;
    }
    if (lane < 8) {
      p.betav[tok * 8 + lane] = sigmf(pr[C_BETA + lane]);
      const float g = -__expf(p.dn_a_log[l * 8 + lane]) * softplusf(pr[C_AR + lane] + p.dn_dt_bias[l * 8 + lane]);
      p.agv[tok * 8 + lane] = g;
    }
  }
}

__device__ __forceinline__ int tok_of(int base, int L, int dir, int tpos) { return base + (dir ? (L - 1 - tpos) : tpos); }


__device__ void s5_task(const P& p, int l, int seq, int dir, int g, char* smem) {
  const int tid = otid(), wid = tid >> 6, lane = tid & 63, fr = lane & 15, fq = lane >> 4;
  const bool ctx = seq < 16;
  const int L = ctx ? 256 : 1024, base = ctx ? seq * 256 : 4096 + (seq - 16) * 1024, Lq = L >> 2;
  const int ldg = (l * 2 + dir) * 32 + g;
  const int pidx = ldg * 64 + lane;
  const float lr = p.lbr[pidx], li = p.lbi[pidx];
  bf16x8 bbf[8];
#pragma unroll
  for (int nt = 0; nt < 8; nt++) {
    const float* src = ((nt < 4) ? p.bbr : p.bbi) + ((size_t)ldg * 64 + (nt & 3) * 16 + fr) * 16;
#pragma unroll
    for (int e = 0; e < 8; e++) {
      const int k = fq * 8 + e;
      const float v = src[k & 15];
      bbf[nt][e] = (short)f2bf((k < 16) ? v : 0.f);
    }
  }
  bf16x8 cf[4];
#pragma unroll
  for (int ks = 0; ks < 4; ks++)
#pragma unroll
    for (int e = 0; e < 8; e++) {
      const int k = ks * 32 + fq * 8 + e;
      const float v = (k < 64) ? p.s5_c_re[((size_t)ldg * 16 + fr) * 64 + k] : -p.s5_c_im[((size_t)ldg * 16 + fr) * 64 + (k - 64)];
      cf[ks][e] = (short)f2bf(v);
    }
  float pr_ = lr, pi_ = li;
  const int nsq = ctx ? 6 : 8;
  for (int i = 0; i < nsq; i++) {
    const float nr = pr_ * pr_ - pi_ * pi_, ni = 2.f * pr_ * pi_;
    pr_ = nr; pi_ = ni;
  }
  bfraw* U16b = (bfraw*)smem + wid * 256;
  float* BUT = (float*)(smem + 2048) + wid * (128 * 20);
  bfraw* H16 = (bfraw*)(smem + 2048 + 4 * 128 * 20 * 4) + wid * (16 * 136);
  float* E = (float*)(smem + 2048 + 4 * 128 * 20 * 4 + 4 * 16 * 136 * 2);
  float* ybuf = p.s5y + (size_t)dir * NT * 512;
  const int nsc = Lq >> 4;
  float h0r = 0.f, h0i = 0.f;
  if (!ctx) {
    const size_t si = ((((size_t)(seq - 16) * 4 + l) * 2 + dir) * 32 + g) * 64 + lane;
    h0r = p.st_s5r[si];
    h0i = p.st_s5i[si];
  }
  float hr = 0.f, hi = 0.f;
  for (int pass = 0; pass < 2; pass++) {
    const int utt = lane >> 2, uq = lane & 3;
    float4 up = *(const float4*)(p.proj + (size_t)tok_of(base, L, dir, wid * Lq + utt) * INWP + C_U + g * 16 + uq * 4);
    for (int sc = 0; sc < nsc; sc++) {
      *(uint2*)(U16b + utt * 16 + uq * 4) = make_uint2(pack2(up.x, up.y), pack2(up.z, up.w));
      __syncthreads();
      if (sc + 1 < nsc) up = *(const float4*)(p.proj + (size_t)tok_of(base, L, dir, wid * Lq + (sc + 1) * 16 + utt) * INWP + C_U + g * 16 + uq * 4);
      {
        bf16x8 a = bf16x8{0, 0, 0, 0, 0, 0, 0, 0};
        if (fq < 2) a = *(const bf16x8*)(U16b + fr * 16 + fq * 8);
#pragma unroll
        for (int nt = 0; nt < 8; nt++) {
          f32x4 acc = f32x4{0.f, 0.f, 0.f, 0.f};
          acc = __builtin_amdgcn_mfma_f32_16x16x32_bf16(a, bbf[nt], acc, 0, 0, 0);
          *(float4*)(BUT + (nt * 16 + fr) * 20 + fq * 4) = make_float4(acc[0], acc[1], acc[2], acc[3]);
        }
      }
      __syncthreads();
      float br[16], bi[16];
#pragma unroll
      for (int c = 0; c < 4; c++) {
        const float4 t0 = *(const float4*)(BUT + lane * 20 + c * 4);
        const float4 t1 = *(const float4*)(BUT + (64 + lane) * 20 + c * 4);
        br[c * 4 + 0] = t0.x; br[c * 4 + 1] = t0.y; br[c * 4 + 2] = t0.z; br[c * 4 + 3] = t0.w;
        bi[c * 4 + 0] = t1.x; bi[c * 4 + 1] = t1.y; bi[c * 4 + 2] = t1.z; bi[c * 4 + 3] = t1.w;
      }
#pragma unroll
      for (int s = 0; s < 16; s++) {
        const float nr = lr * hr - li * hi + br[s];
        const float ni = lr * hi + li * hr + bi[s];
        hr = nr; hi = ni;
        if (pass == 1) {
          H16[s * 136 + lane] = f2bf(hr);
          H16[s * 136 + 64 + lane] = f2bf(hi);
        }
      }
      if (pass == 1) {
        __syncthreads();
        f32x4 acc = f32x4{0.f, 0.f, 0.f, 0.f};
#pragma unroll
        for (int ks = 0; ks < 4; ks++) {
          const bf16x8 a = *(const bf16x8*)(H16 + fr * 136 + ks * 32 + fq * 8);
          acc = __builtin_amdgcn_mfma_f32_16x16x32_bf16(cf[ks], a, acc, 0, 0, 0);
        }
        {
          const int tok = tok_of(base, L, dir, wid * Lq + sc * 16 + fr);
          *(float4*)(ybuf + (size_t)tok * 512 + g * 16 + fq * 4) = make_float4(acc[0], acc[1], acc[2], acc[3]);
        }
      }
    }
    if (pass == 0) {
      E[(wid * 64 + lane) * 2 + 0] = hr;
      E[(wid * 64 + lane) * 2 + 1] = hi;
      __syncthreads();
      float er = h0r, ei = h0i;
      for (int w = 0; w < wid; w++) {
        const float nr = pr_ * er - pi_ * ei + E[(w * 64 + lane) * 2 + 0];
        const float ni = pr_ * ei + pi_ * er + E[(w * 64 + lane) * 2 + 1];
        er = nr; ei = ni;
      }
      hr = er; hi = ei;
    }
  }
  if (ctx && wid == 3) {
    const size_t oi = ((((size_t)seq * 4 + l) * 2 + dir) * 32 + g) * 64 + lane;
    p.out[O_S5R + oi] = hr;
    p.out[O_S5I + oi] = hi;
  }
  __syncthreads();
}


__device__ void ssd_task(const P& p, int l, int seq, int dir, int hd, char* smem) {
  const int tid = otid(), wid = tid >> 6, lane = tid & 63, fr = lane & 15, fq = lane >> 4;
  const int mt = wid >> 1, ph = wid & 1;
  const bool ctx = seq < 16;
  const int L = ctx ? 256 : 1024, base = ctx ? seq * 256 : 4096 + (seq - 16) * 1024;
  const int nch = L >> 5, grp = hd >> 2;
  bfraw* Craw = (bfraw*)smem;
  bfraw* Braw = Craw + 32 * 72;
  bfraw* Hb = Braw + 32 * 72;
  bfraw* BwT = Hb + 64 * 72;
  bfraw* XdtT = BwT + 64 * 40;
  bfraw* Sd = XdtT + 64 * 40;
  float* acs = (float*)(Sd + 32 * 40);
  bfraw* BwL = (bfraw*)(acs + 32);
  bfraw* XdL = BwL + 64 * 40;
  float* ybuf = p.ssdy + (size_t)dir * NT * 512;
  f32x4 H0, H1, H2, H3;
  H0 = f32x4{0.f, 0.f, 0.f, 0.f}; H1 = H0; H2 = H0; H3 = H0;
  if (!ctx) {
    const float* st = p.st_ssd + (((((size_t)(seq - 16) * 4 + l) * 2 + dir) * 8 + hd) * 64) * 64 + wid * 16 + fq * 4;
    const float4 v0 = *(const float4*)(st + (size_t)(0 * 16 + fr) * 64);
    const float4 v1 = *(const float4*)(st + (size_t)(1 * 16 + fr) * 64);
    const float4 v2 = *(const float4*)(st + (size_t)(2 * 16 + fr) * 64);
    const float4 v3 = *(const float4*)(st + (size_t)(3 * 16 + fr) * 64);
    H0 = f32x4{v0.x, v0.y, v0.z, v0.w}; H1 = f32x4{v1.x, v1.y, v1.z, v1.w};
    H2 = f32x4{v2.x, v2.y, v2.z, v2.w}; H3 = f32x4{v3.x, v3.y, v3.z, v3.w};
  }
  const int i0 = (tid >> 4) * 2, c4 = tid & 15;
  float4 rC0, rC1, rB0, rB1, rX0, rX1;
  float rdt0, rdt1, rla = 0.f;
#define SSD_PREFETCH(CH)                                                        \
  {                                                                             \
    const int t0 = tok_of(base, L, dir, (CH) * 32 + i0);                        \
    const int t1 = tok_of(base, L, dir, (CH) * 32 + i0 + 1);                   \
    const float* r0 = p.xbc + (size_t)t0 * 768;                                 \
    const float* r1 = p.xbc + (size_t)t1 * 768;                                 \
    rB0 = *(const float4*)(r0 + 512 + grp * 64 + c4 * 4);                       \
    rB1 = *(const float4*)(r1 + 512 + grp * 64 + c4 * 4);                       \
    rC0 = *(const float4*)(r0 + 640 + grp * 64 + c4 * 4);                       \
    rC1 = *(const float4*)(r1 + 640 + grp * 64 + c4 * 4);                       \
    rX0 = *(const float4*)(r0 + hd * 64 + c4 * 4);                              \
    rX1 = *(const float4*)(r1 + hd * 64 + c4 * 4);                              \
    if (tid < 32) rla = p.dAv[tok_of(base, L, dir, (CH) * 32 + tid) * 16 + dir * 8 + hd]; \
    rdt0 = p.dtv[t0 * 16 + dir * 8 + hd];                                       \
    rdt1 = p.dtv[t1 * 16 + dir * 8 + hd];                                       \
  }
  SSD_PREFETCH(0)
  for (int ch = 0; ch < nch; ch++) {
    __syncthreads();
    if (tid < 64) {
      float g = (lane < 32) ? rla : 0.f;
#pragma unroll
      for (int o = 1; o < 32; o <<= 1) {
        const float t = __shfl_up(g, o, 64);
        if (lane >= o) g += t;
      }
      if (lane < 32) acs[lane] = g;
    }
    __syncthreads();
    const float acl = acs[31];
    const float rac0 = acs[i0], rac1 = acs[i0 + 1];
    {
      *(uint2*)(Craw + i0 * 72 + c4 * 4) = make_uint2(pack2(rC0.x, rC0.y), pack2(rC0.z, rC0.w));
      *(uint2*)(Craw + (i0 + 1) * 72 + c4 * 4) = make_uint2(pack2(rC1.x, rC1.y), pack2(rC1.z, rC1.w));
      *(uint2*)(Braw + i0 * 72 + c4 * 4) = make_uint2(pack2(rB0.x, rB0.y), pack2(rB0.z, rB0.w));
      *(uint2*)(Braw + (i0 + 1) * 72 + c4 * 4) = make_uint2(pack2(rB1.x, rB1.y), pack2(rB1.z, rB1.w));
      const float w0 = __expf(acl - rac0), w1 = __expf(acl - rac1);
#define SSD_HL2(ARR, LO, ROW, V0, V1)                                                         \
  {                                                                                           \
    const float a_ = (V0), b_ = (V1);                                                         \
    const bfraw ha = f2bf(a_), hb = f2bf(b_);                                                 \
    *(unsigned*)(ARR + (ROW) * 40 + i0) = (unsigned)ha | ((unsigned)hb << 16);                \
    *(unsigned*)(LO + (ROW) * 40 + i0) = pack2(a_ - __uint_as_float((unsigned)ha << 16),     \
                                               b_ - __uint_as_float((unsigned)hb << 16));    \
  }
      SSD_HL2(BwT, BwL, c4 * 4 + 0, rB0.x * w0, rB1.x * w1)
      SSD_HL2(BwT, BwL, c4 * 4 + 1, rB0.y * w0, rB1.y * w1)
      SSD_HL2(BwT, BwL, c4 * 4 + 2, rB0.z * w0, rB1.z * w1)
      SSD_HL2(BwT, BwL, c4 * 4 + 3, rB0.w * w0, rB1.w * w1)
      SSD_HL2(XdtT, XdL, c4 * 4 + 0, rX0.x * rdt0, rX1.x * rdt1)
      SSD_HL2(XdtT, XdL, c4 * 4 + 1, rX0.y * rdt0, rX1.y * rdt1)
      SSD_HL2(XdtT, XdL, c4 * 4 + 2, rX0.z * rdt0, rX1.z * rdt1)
      SSD_HL2(XdtT, XdL, c4 * 4 + 3, rX0.w * rdt0, rX1.w * rdt1)
#undef SSD_HL2
      *(uint2*)(Hb + (0 * 16 + fr) * 72 + wid * 16 + fq * 4) = make_uint2(pack2(H0[0], H0[1]), pack2(H0[2], H0[3]));
      *(uint2*)(Hb + (1 * 16 + fr) * 72 + wid * 16 + fq * 4) = make_uint2(pack2(H1[0], H1[1]), pack2(H1[2], H1[3]));
      *(uint2*)(Hb + (2 * 16 + fr) * 72 + wid * 16 + fq * 4) = make_uint2(pack2(H2[0], H2[1]), pack2(H2[2], H2[3]));
      *(uint2*)(Hb + (3 * 16 + fr) * 72 + wid * 16 + fq * 4) = make_uint2(pack2(H3[0], H3[1]), pack2(H3[2], H3[3]));
    }
    __syncthreads();
    if (ch + 1 < nch) SSD_PREFETCH(ch + 1)
    f32x4 sc = f32x4{0.f, 0.f, 0.f, 0.f}, Y0 = sc, Y1 = sc;
#pragma unroll
    for (int ks = 0; ks < 2; ks++) {
      const bf16x8 ac_ = *(const bf16x8*)(Craw + (mt * 16 + fr) * 72 + ks * 32 + fq * 8);
      const bf16x8 bb = *(const bf16x8*)(Braw + (ph * 16 + fr) * 72 + ks * 32 + fq * 8);
      const bf16x8 h0 = *(const bf16x8*)(Hb + ((2 * ph + 0) * 16 + fr) * 72 + ks * 32 + fq * 8);
      const bf16x8 h1 = *(const bf16x8*)(Hb + ((2 * ph + 1) * 16 + fr) * 72 + ks * 32 + fq * 8);
      sc = __builtin_amdgcn_mfma_f32_16x16x32_bf16(bb, ac_, sc, 0, 0, 0);
      Y0 = __builtin_amdgcn_mfma_f32_16x16x32_bf16(h0, ac_, Y0, 0, 0, 0);
      Y1 = __builtin_amdgcn_mfma_f32_16x16x32_bf16(h1, ac_, Y1, 0, 0, 0);
    }
    {
      const int i = mt * 16 + fr;
      const float ai = acs[i];
      float sv[4];
#pragma unroll
      for (int j = 0; j < 4; j++) {
        const int jj = ph * 16 + fq * 4 + j;
        const float d = fminf(ai - acs[jj], 0.f);
        sv[j] = (i >= jj) ? sc[j] * __expf(d) : 0.f;
      }
      *(uint2*)(Sd + i * 40 + ph * 16 + fq * 4) = make_uint2(pack2(sv[0], sv[1]), pack2(sv[2], sv[3]));
    }
    {
      const float e = __expf(acs[mt * 16 + fr]);
      Y0 *= e;
      Y1 *= e;
    }
    __syncthreads();
    {
      const bf16x8 a = *(const bf16x8*)(Sd + (mt * 16 + fr) * 40 + fq * 8);
      const bf16x8 x0 = *(const bf16x8*)(XdtT + ((2 * ph + 0) * 16 + fr) * 40 + fq * 8);
      const bf16x8 x1 = *(const bf16x8*)(XdtT + ((2 * ph + 1) * 16 + fr) * 40 + fq * 8);
      Y0 = __builtin_amdgcn_mfma_f32_16x16x32_bf16(x0, a, Y0, 0, 0, 0);
      Y1 = __builtin_amdgcn_mfma_f32_16x16x32_bf16(x1, a, Y1, 0, 0, 0);
      {
        const int tok = tok_of(base, L, dir, ch * 32 + mt * 16 + fr);
        float* yr = ybuf + (size_t)tok * 512 + hd * 64 + fq * 4;
        *(float4*)(yr + (2 * ph + 0) * 16) = make_float4(Y0[0], Y0[1], Y0[2], Y0[3]);
        *(float4*)(yr + (2 * ph + 1) * 16) = make_float4(Y1[0], Y1[1], Y1[2], Y1[3]);
      }
    }
    {
      const float eL = __expf(acl);
      const bf16x8 a = *(const bf16x8*)(BwT + (wid * 16 + fr) * 40 + fq * 8);
      const bf16x8 x0 = *(const bf16x8*)(XdtT + (0 * 16 + fr) * 40 + fq * 8);
      const bf16x8 x1 = *(const bf16x8*)(XdtT + (1 * 16 + fr) * 40 + fq * 8);
      const bf16x8 x2 = *(const bf16x8*)(XdtT + (2 * 16 + fr) * 40 + fq * 8);
      const bf16x8 x3 = *(const bf16x8*)(XdtT + (3 * 16 + fr) * 40 + fq * 8);
      H0 *= eL; H1 *= eL; H2 *= eL; H3 *= eL;
      const bf16x8 al = *(const bf16x8*)(BwL + (wid * 16 + fr) * 40 + fq * 8);
      const bf16x8 y0 = *(const bf16x8*)(XdL + (0 * 16 + fr) * 40 + fq * 8);
      const bf16x8 y1 = *(const bf16x8*)(XdL + (1 * 16 + fr) * 40 + fq * 8);
      const bf16x8 y2 = *(const bf16x8*)(XdL + (2 * 16 + fr) * 40 + fq * 8);
      const bf16x8 y3 = *(const bf16x8*)(XdL + (3 * 16 + fr) * 40 + fq * 8);
      H0 = __builtin_amdgcn_mfma_f32_16x16x32_bf16(a, x0, H0, 0, 0, 0);
      H1 = __builtin_amdgcn_mfma_f32_16x16x32_bf16(a, x1, H1, 0, 0, 0);
      H2 = __builtin_amdgcn_mfma_f32_16x16x32_bf16(a, x2, H2, 0, 0, 0);
      H3 = __builtin_amdgcn_mfma_f32_16x16x32_bf16(a, x3, H3, 0, 0, 0);
      H0 = __builtin_amdgcn_mfma_f32_16x16x32_bf16(al, x0, H0, 0, 0, 0);
      H1 = __builtin_amdgcn_mfma_f32_16x16x32_bf16(al, x1, H1, 0, 0, 0);
      H2 = __builtin_amdgcn_mfma_f32_16x16x32_bf16(al, x2, H2, 0, 0, 0);
      H3 = __builtin_amdgcn_mfma_f32_16x16x32_bf16(al, x3, H3, 0, 0, 0);
      H0 = __builtin_amdgcn_mfma_f32_16x16x32_bf16(a, y0, H0, 0, 0, 0);
      H1 = __builtin_amdgcn_mfma_f32_16x16x32_bf16(a, y1, H1, 0, 0, 0);
      H2 = __builtin_amdgcn_mfma_f32_16x16x32_bf16(a, y2, H2, 0, 0, 0);
      H3 = __builtin_amdgcn_mfma_f32_16x16x32_bf16(a, y3, H3, 0, 0, 0);
    }
  }
#undef SSD_PREFETCH
  if (ctx) {
    float* st = p.out + O_SSD + (((((size_t)seq * 4 + l) * 2 + dir) * 8 + hd) * 64) * 64 + wid * 16 + fq * 4;
    *(float4*)(st + (size_t)(0 * 16 + fr) * 64) = make_float4(H0[0], H0[1], H0[2], H0[3]);
    *(float4*)(st + (size_t)(1 * 16 + fr) * 64) = make_float4(H1[0], H1[1], H1[2], H1[3]);
    *(float4*)(st + (size_t)(2 * 16 + fr) * 64) = make_float4(H2[0], H2[1], H2[2], H2[3]);
    *(float4*)(st + (size_t)(3 * 16 + fr) * 64) = make_float4(H3[0], H3[1], H3[2], H3[3]);
  }
  __syncthreads();
}


__device__ void dnpre_task(const P& p, int task, char* smem) {
  const int tid = otid(), wid = tid >> 6, lane = tid & 63, fr = lane & 15, fq = lane >> 4;
  const int hd = task & 3, dir = (task >> 2) & 1, cg = task >> 3;
  int base, L;
  if (cg < 128) { base = (cg >> 3) * 256; L = 256; } else { base = 4096 + ((cg - 128) >> 5) * 1024; L = 1024; }
  const int c = cg - (base >> 5);
  const size_t tb = (size_t)task;
  bfraw* Kb = (bfraw*)smem;
  bfraw* Qb = Kb + 32 * 136;
  float* Msm = (float*)(smem + 2 * 32 * 136 * 2);
  float* gcs = Msm + 32 * 36;
  float* bts = gcs + 32;
  if (tid < 64) {
    float g = 0.f, b = 0.f;
    if (lane < 32) {
      const int tok = tok_of(base, L, dir, c * 32 + lane);
      g = p.agv[tok * 8 + dir * 4 + hd];
      b = p.betav[tok * 8 + dir * 4 + hd];
    }
#pragma unroll
    for (int o = 1; o < 32; o <<= 1) {
      const float t = __shfl_up(g, o, 64);
      if (lane >= o) g += t;
    }
    if (lane < 32) { gcs[lane] = g; bts[lane] = b; }
  }
  __syncthreads();
#pragma unroll
  for (int e = 0; e < 4; e++) {
    const int idx = tid + 256 * e, i = idx >> 5, c4 = idx & 31;
    const int tok = tok_of(base, L, dir, c * 32 + i);
    const float* r = p.qkv + (size_t)tok * 1536 + hd * 128 + c4 * 4;
    const float4 q4 = *(const float4*)r;
    const float4 k4 = *(const float4*)(r + 512);
    const float Ai = __expf(gcs[i]);
    *(uint2*)(Kb + i * 136 + c4 * 4) = make_uint2(pack2(k4.x, k4.y), pack2(k4.z, k4.w));
    *(uint2*)(Qb + i * 136 + c4 * 4) = make_uint2(pack2(q4.x, q4.y), pack2(q4.z, q4.w));
    *(uint2*)(p.dn_qa + (tb * 32 + i) * 128 + c4 * 4) = make_uint2(pack2(q4.x * Ai, q4.y * Ai), pack2(q4.z * Ai, q4.w * Ai));
  }
  __syncthreads();
  {
    const int mt = wid >> 1, nt = wid & 1;
    f32x4 accK = f32x4{0.f, 0.f, 0.f, 0.f}, accQ = f32x4{0.f, 0.f, 0.f, 0.f};
#pragma unroll
    for (int ks = 0; ks < 4; ks++) {
      const bf16x8 ak = *(const bf16x8*)(Kb + (mt * 16 + fr) * 136 + ks * 32 + fq * 8);
      const bf16x8 aq = *(const bf16x8*)(Qb + (mt * 16 + fr) * 136 + ks * 32 + fq * 8);
      const bf16x8 bk = *(const bf16x8*)(Kb + (nt * 16 + fr) * 136 + ks * 32 + fq * 8);
      accK = __builtin_amdgcn_mfma_f32_16x16x32_bf16(ak, bk, accK, 0, 0, 0);
      accQ = __builtin_amdgcn_mfma_f32_16x16x32_bf16(aq, bk, accQ, 0, 0, 0);
    }
#pragma unroll
    for (int j = 0; j < 4; j++) {
      const int i = mt * 16 + fq * 4 + j, jj = nt * 16 + fr;
      const float d = fminf(gcs[i] - gcs[jj], 0.f);
      const float dec = (i >= jj) ? __expf(d) : 0.f;
      Msm[i * 36 + jj] = (i > jj) ? bts[i] * accK[j] * dec : 0.f;
      p.dn_qkd[(tb * 32 + i) * 32 + jj] = f2bf(accQ[j] * dec);
    }
  }
  __syncthreads();
  {
    const bool isU = tid < 128;
    const int colofs = isU ? (1024 + hd * 128 + tid) : (512 + hd * 128 + (tid - 128));
    float x[32];
#pragma unroll
    for (int i = 0; i < 32; i++) {
      const int tok = tok_of(base, L, dir, c * 32 + i);
      const float sc = isU ? bts[i] : bts[i] * __expf(gcs[i]);
      x[i] = sc * p.qkv[(size_t)tok * 1536 + colofs];
    }
#pragma unroll
    for (int i = 1; i < 32; i++) {
      float sacc = x[i];
#pragma unroll
      for (int j = 0; j < i; j++) sacc -= Msm[i * 36 + j] * x[j];
      x[i] = sacc;
    }
    if (isU) {
#pragma unroll
      for (int i = 0; i < 32; i++) p.dn_u[(tb * 32 + i) * 128 + tid] = x[i];
    } else {
#pragma unroll
      for (int i = 0; i < 32; i++) p.dn_w[(tb * 32 + i) * 128 + (tid - 128)] = f2bf(x[i]);
    }
  }
  {
    const int dk = tid & 127, half = tid >> 7;
    const float gl = gcs[31];
    unsigned w[8];
#pragma unroll
    for (int e = 0; e < 8; e++) {
      const int j0 = half * 16 + 2 * e;
      const float k0 = p.qkv[(size_t)tok_of(base, L, dir, c * 32 + j0) * 1536 + 512 + hd * 128 + dk] * __expf(gl - gcs[j0]);
      const float k1 = p.qkv[(size_t)tok_of(base, L, dir, c * 32 + j0 + 1) * 1536 + 512 + hd * 128 + dk] * __expf(gl - gcs[j0 + 1]);
      w[e] = pack2(k0, k1);
    }
    bfraw* d = p.dn_kwt + (tb * 128 + dk) * 32 + half * 16;
    *(uint4*)d = make_uint4(w[0], w[1], w[2], w[3]);
    *(uint4*)(d + 8) = make_uint4(w[4], w[5], w[6], w[7]);
    if (tid == 0) p.dn_ac[tb] = __expf(gl);
  }
  __syncthreads();
}

__device__ void dnseq_task(const P& p, int l, int seq, int dir, int hd, int dvs, char* smem) {
  const int tid = otid(), wid = tid >> 6, lane = tid & 63, fr = lane & 15, fq = lane >> 4;
  const int mt = wid >> 1, nt = wid & 1;
  const bool ctx = seq < 16;
  const int L = ctx ? 256 : 1024, base = ctx ? seq * 256 : 4096 + (seq - 16) * 1024;
  const int nch = L >> 5;
  bfraw* Wm = (bfraw*)smem;
  bfraw* QAs = Wm + 32 * 136;
  bfraw* SbT = QAs + 32 * 136;
  bfraw* KwTs = SbT + 32 * 136;
  bfraw* QKds = KwTs + 128 * 40;
  bfraw* VnT = QKds + 32 * 40;
  float* obuf = p.dny + (size_t)dir * NT * 512;
  f32x4 S00, S01, S10, S11;
  S00 = f32x4{0.f, 0.f, 0.f, 0.f}; S01 = S00; S10 = S00; S11 = S00;
  if (!ctx) {
    const float* st = p.st_dn + (((((size_t)(seq - 16) * 4 + l) * 2 + dir) * 4 + hd) * 128) * 128 + dvs * 32 + fr;
#pragma unroll
    for (int j = 0; j < 4; j++) {
      S00[j] = st[(size_t)((2 * wid + 0) * 16 + fq * 4 + j) * 128];
      S01[j] = st[(size_t)((2 * wid + 0) * 16 + fq * 4 + j) * 128 + 16];
      S10[j] = st[(size_t)((2 * wid + 1) * 16 + fq * 4 + j) * 128];
      S11[j] = st[(size_t)((2 * wid + 1) * 16 + fq * 4 + j) * 128 + 16];
    }
  }
  const size_t slot0 = ((size_t)(base >> 5) * 2 + dir) * 4 + hd;
  uint4 rW0, rW1, rQ0, rQ1, rK0, rK1, rD;
  float rU0, rU1, rU2, rU3, rA;
  rD = make_uint4(0, 0, 0, 0);
#define DNS_PREFETCH(CH)                                                                          \
  {                                                                                               \
    const size_t sl = slot0 + (size_t)(CH) * 8;                                                   \
    rW0 = *(const uint4*)(p.dn_w + sl * 4096 + (size_t)tid * 8);                                  \
    rW1 = *(const uint4*)(p.dn_w + sl * 4096 + (size_t)(tid + 256) * 8);                          \
    rQ0 = *(const uint4*)(p.dn_qa + sl * 4096 + (size_t)tid * 8);                                 \
    rQ1 = *(const uint4*)(p.dn_qa + sl * 4096 + (size_t)(tid + 256) * 8);                         \
    rK0 = *(const uint4*)(p.dn_kwt + sl * 4096 + (size_t)tid * 8);                                \
    rK1 = *(const uint4*)(p.dn_kwt + sl * 4096 + (size_t)(tid + 256) * 8);                        \
    if (tid < 128) rD = *(const uint4*)(p.dn_qkd + sl * 1024 + (size_t)tid * 8);                  \
    const float* up = p.dn_u + (sl * 32 + mt * 16 + fq * 4) * 128 + dvs * 32 + nt * 16 + fr;      \
    rU0 = up[0]; rU1 = up[128]; rU2 = up[256]; rU3 = up[384];                                     \
    rA = p.dn_ac[sl];                                                                             \
  }
  DNS_PREFETCH(0)
  for (int ch = 0; ch < nch; ch++) {
    __syncthreads();
    *(uint4*)(Wm + (tid >> 4) * 136 + (tid & 15) * 8) = rW0;
    *(uint4*)(Wm + ((tid >> 4) + 16) * 136 + (tid & 15) * 8) = rW1;
    *(uint4*)(QAs + (tid >> 4) * 136 + (tid & 15) * 8) = rQ0;
    *(uint4*)(QAs + ((tid >> 4) + 16) * 136 + (tid & 15) * 8) = rQ1;
    *(uint4*)(KwTs + (tid >> 2) * 40 + (tid & 3) * 8) = rK0;
    *(uint4*)(KwTs + ((tid >> 2) + 64) * 40 + (tid & 3) * 8) = rK1;
    if (tid < 128) *(uint4*)(QKds + (tid >> 2) * 40 + (tid & 3) * 8) = rD;
    *(uint2*)(SbT + (fr) * 136 + (2 * wid + 0) * 16 + fq * 4) = make_uint2(pack2(S00[0], S00[1]), pack2(S00[2], S00[3]));
    *(uint2*)(SbT + (16 + fr) * 136 + (2 * wid + 0) * 16 + fq * 4) = make_uint2(pack2(S01[0], S01[1]), pack2(S01[2], S01[3]));
    *(uint2*)(SbT + (fr) * 136 + (2 * wid + 1) * 16 + fq * 4) = make_uint2(pack2(S10[0], S10[1]), pack2(S10[2], S10[3]));
    *(uint2*)(SbT + (16 + fr) * 136 + (2 * wid + 1) * 16 + fq * 4) = make_uint2(pack2(S11[0], S11[1]), pack2(S11[2], S11[3]));
    const float u0 = rU0, u1 = rU1, u2 = rU2, u3 = rU3, ac = rA;
    __syncthreads();
    if (ch + 1 < nch) DNS_PREFETCH(ch + 1)
    f32x4 accW = f32x4{0.f, 0.f, 0.f, 0.f}, accQ = f32x4{0.f, 0.f, 0.f, 0.f};
#pragma unroll
    for (int ks = 0; ks < 4; ks++) {
      const bf16x8 aw = *(const bf16x8*)(Wm + (mt * 16 + fr) * 136 + ks * 32 + fq * 8);
      const bf16x8 aq = *(const bf16x8*)(QAs + (mt * 16 + fr) * 136 + ks * 32 + fq * 8);
      const bf16x8 bs = *(const bf16x8*)(SbT + (nt * 16 + fr) * 136 + ks * 32 + fq * 8);
      accW = __builtin_amdgcn_mfma_f32_16x16x32_bf16(aw, bs, accW, 0, 0, 0);
      accQ = __builtin_amdgcn_mfma_f32_16x16x32_bf16(bs, aq, accQ, 0, 0, 0);
    }
    *(uint2*)(VnT + (nt * 16 + fr) * 40 + mt * 16 + fq * 4) =
        make_uint2(pack2(u0 - accW[0], u1 - accW[1]), pack2(u2 - accW[2], u3 - accW[3]));
    __syncthreads();
    {
      const bf16x8 a = *(const bf16x8*)(QKds + (mt * 16 + fr) * 40 + fq * 8);
      const bf16x8 b = *(const bf16x8*)(VnT + (nt * 16 + fr) * 40 + fq * 8);
      accQ = __builtin_amdgcn_mfma_f32_16x16x32_bf16(b, a, accQ, 0, 0, 0);
      {
        const int tok = tok_of(base, L, dir, ch * 32 + mt * 16 + fr);
        *(float4*)(obuf + (size_t)tok * 512 + hd * 128 + dvs * 32 + nt * 16 + fq * 4) = make_float4(accQ[0], accQ[1], accQ[2], accQ[3]);
      }
    }
    {
      const bf16x8 b0 = *(const bf16x8*)(VnT + (fr) * 40 + fq * 8);
      const bf16x8 b1 = *(const bf16x8*)(VnT + (16 + fr) * 40 + fq * 8);
      const bf16x8 a0 = *(const bf16x8*)(KwTs + ((2 * wid + 0) * 16 + fr) * 40 + fq * 8);
      const bf16x8 a1 = *(const bf16x8*)(KwTs + ((2 * wid + 1) * 16 + fr) * 40 + fq * 8);
      S00 *= ac; S01 *= ac; S10 *= ac; S11 *= ac;
      S00 = __builtin_amdgcn_mfma_f32_16x16x32_bf16(a0, b0, S00, 0, 0, 0);
      S01 = __builtin_amdgcn_mfma_f32_16x16x32_bf16(a0, b1, S01, 0, 0, 0);
      S10 = __builtin_amdgcn_mfma_f32_16x16x32_bf16(a1, b0, S10, 0, 0, 0);
      S11 = __builtin_amdgcn_mfma_f32_16x16x32_bf16(a1, b1, S11, 0, 0, 0);
    }
  }
#undef DNS_PREFETCH
  if (ctx) {
    float* st = p.out + O_DN + (((((size_t)seq * 4 + l) * 2 + dir) * 4 + hd) * 128) * 128 + dvs * 32 + fr;
#pragma unroll
    for (int j = 0; j < 4; j++) {
      st[(size_t)((2 * wid + 0) * 16 + fq * 4 + j) * 128] = S00[j];
      st[(size_t)((2 * wid + 0) * 16 + fq * 4 + j) * 128 + 16] = S01[j];
      st[(size_t)((2 * wid + 1) * 16 + fq * 4 + j) * 128] = S10[j];
      st[(size_t)((2 * wid + 1) * 16 + fq * 4 + j) * 128 + 16] = S11[j];
    }
  }
  __syncthreads();
}

__device__ void phase_dnpre(const P& p, char* smem) {
  for (int t = obid(); t < 1536; t += gridDim.x) dnpre_task(p, t, smem);
}

__device__ void phase_scan(const P& p, int l, char* smem) {
  __shared__ int s_task;
  for (;;) {
    if (otid() == 0) s_task = atomicAdd(&p.ctr[l], 1);
    __syncthreads();
    int t = __builtin_amdgcn_readfirstlane(s_task);
    __syncthreads();
    const int NX = 0;
    if (t >= 480) {
      if (t < 480 + NX) {
        t -= 480;
        convert_one(p, l + 1, t, smem);
        continue;
      }
      t -= NX;
      if (t >= 2016) break;
    }
    if (t < 32) {
      ssd_task(p, l, 16 + (t >> 4), (t >> 3) & 1, t & 7, smem);
    } else if (t < 288) {
      t -= 32;
      ssd_task(p, l, t >> 4, (t >> 3) & 1, t & 7, smem);
    } else if (t < 416) {
      t -= 288;
      s5_task(p, l, 16 + (t >> 6), (t >> 5) & 1, t & 31, smem);
    } else if (t < 480) {
      t -= 416;
      dnseq_task(p, l, 16 + (t >> 5), (t >> 4) & 1, (t >> 2) & 3, t & 3, smem);
    } else if (t < 1504) {
      t -= 480;
      s5_task(p, l, t >> 6, (t >> 5) & 1, t & 31, smem);
    } else {
      t -= 1504;
      dnseq_task(p, l, t >> 5, (t >> 4) & 1, (t >> 2) & 3, t & 3, smem);
    }
  }
}

__device__ void phase_post(const P& p, int l) {
  const int wid = otid() >> 6, lane = otid() & 63;
  for (int tok = obid() * 4 + wid; tok < NT; tok += gridDim.x * 4) {
    const float* pr = p.proj + (size_t)tok * INWP;
    const size_t o5 = (size_t)tok * 512;
#pragma unroll
    for (int i = 0; i < 2; i++) {
      const int c = lane * 4 + 256 * i;
      const float4 yf = *(const float4*)(p.s5y + o5 + c), yb = *(const float4*)(p.s5y + (size_t)NT * 512 + o5 + c);
      const float4 d = *(const float4*)(p.s5_d + l * 512 + c), u = *(const float4*)(pr + C_U + c);
      const float y0 = yf.x + yb.x + d.x * u.x, y1 = yf.y + yb.y + d.y * u.y, y2 = yf.z + yb.z + d.z * u.z, y3 = yf.w + yb.w + d.w * u.w;
      *(uint2*)(p.a_s5 + o5 + c) = make_uint2(pack2(gelu_tanh(y0), gelu_tanh(y1)), pack2(gelu_tanh(y2), gelu_tanh(y3)));
    }
    {
      float4 y[2];
      float ss = 0.f;
#pragma unroll
      for (int i = 0; i < 2; i++) {
        const int c = lane * 4 + 256 * i;
        const float4 yf = *(const float4*)(p.ssdy + o5 + c), yb = *(const float4*)(p.ssdy + (size_t)NT * 512 + o5 + c);
        const float4 xs = *(const float4*)(p.xbc + (size_t)tok * 768 + c), z = *(const float4*)(pr + C_Z + c);
        const float dd = p.ssd_d[l * 8 + (c >> 6)];
        y[i].x = (yf.x + yb.x + dd * xs.x) * siluf(z.x);
        y[i].y = (yf.y + yb.y + dd * xs.y) * siluf(z.y);
        y[i].z = (yf.z + yb.z + dd * xs.z) * siluf(z.z);
        y[i].w = (yf.w + yb.w + dd * xs.w) * siluf(z.w);
        ss += y[i].x * y[i].x + y[i].y * y[i].y + y[i].z * y[i].z + y[i].w * y[i].w;
      }
      ss = wave_sum(ss);
      const float r = rsqrtf(ss * (1.f / 512.f) + EPSF);
#pragma unroll
      for (int i = 0; i < 2; i++) {
        const int c = lane * 4 + 256 * i;
        const float4 gn = *(const float4*)(p.ssd_norm_g + l * 512 + c);
        *(uint2*)(p.a_ssd + o5 + c) = make_uint2(pack2(y[i].x * r * gn.x, y[i].y * r * gn.y), pack2(y[i].z * r * gn.z, y[i].w * r * gn.w));
      }
    }
#pragma unroll
    for (int i = 0; i < 2; i++) {
      const int c = lane * 4 + 256 * i;
      const float4 of = *(const float4*)(p.dny + o5 + c), ob = *(const float4*)(p.dny + (size_t)NT * 512 + o5 + c);
      const float o0 = of.x + ob.x, o1 = of.y + ob.y, o2 = of.z + ob.z, o3 = of.w + ob.w;
      const float ss = half_sum(o0 * o0 + o1 * o1 + o2 * o2 + o3 * o3);
      const float r = rsqrtf(ss * (1.f / 128.f) + EPSF);
      const float4 gn = *(const float4*)(p.dn_norm_g + l * 128 + (c & 127));
      const float4 gt = *(const float4*)(pr + C_DNG + c);
      *(uint2*)(p.a_dn + o5 + c) = make_uint2(pack2(o0 * r * gn.x * siluf(gt.x), o1 * r * gn.y * siluf(gt.y)),
                                              pack2(o2 * r * gn.z * siluf(gt.z), o3 * r * gn.w * siluf(gt.w)));
    }
  }
}

__global__ void __launch_bounds__(256, 2) fwd_megakernel(P p) {
  cg::grid_group grid = cg::this_grid();
  __shared__ __attribute__((aligned(16))) char smem[SMEM_BYTES];
  __shared__ uint4 xb_words;
  if (threadIdx.x == 0) xb_words = make_uint4(0u, 0u, 0u, 0u);
  __syncthreads();
  XcdBarrier xb = xcd_barrier_post(p.bar, (volatile LAS unsigned*)&xb_words);
  phase_init(p, smem);
  __syncthreads();
  for (int t = obid(); t < NCONV + 576; t += gridDim.x) {
    if (t < 576) ada_one(p, t / 144, t % 144, smem);
    else convert_one(p, 0, t - 576, smem);
  }
#define GSYNC() xcd_barrier(xb)
  if (p.out == nullptr) grid.sync();
  GSYNC();
  for (int l = 0; l < 4; l++) {
    const float* modl = p.mod + (size_t)l * 3 * 9216;
    const size_t wo = (size_t)(l & 1) * WT_SET;
    phase_normmod(p, l, 0); GSYNC();
    phase_swiglu(p, p.wt_wi + wo, smem); GSYNC();
    phase_resid(p, p.act, p.wt_wo + wo, DFF, modl + 2 * 1024, 0.5f, (l < 3) ? l + 1 : -1, 0, 700, smem); GSYNC();
    phase_normmod(p, l, 1); GSYNC();
    phase_proj(p, wo, smem); GSYNC();
    phase_prep(p, l); GSYNC();
    phase_dnpre(p, smem); GSYNC();
    phase_scan(p, l, smem); GSYNC();
    phase_post(p, l); GSYNC();
    phase_merge(p, wo, smem); GSYNC();
    phase_resid(p, p.h, p.wt_wout + wo, DM, modl + 5 * 1024, 1.0f, (l < 3) ? l + 1 : -1, 700, 950, smem); GSYNC();
    phase_normmod(p, l, 2); GSYNC();
    phase_swiglu(p, p.wt_wi + wo + (size_t)5632 * 1024, smem); GSYNC();
    phase_resid(p, p.act, p.wt_wo + wo + (size_t)1024 * 2816, DFF, modl + 8 * 1024, 0.5f, (l < 3) ? l + 1 : -1, 950, NCONV, smem); GSYNC();
  }
  phase_final(p);
}

extern "C" void kernel_launch(void* const* d_in, const int* in_sizes, int n_in, void* d_out, int out_size, void* d_ws,
                              size_t ws_size, hipStream_t stream) {
  static int grid_blocks = 0;
  if (!grid_blocks) {
    int dev = 0, cus = 0, per_cu = 0;
    hipGetDevice(&dev);
    hipDeviceGetAttribute(&cus, hipDeviceAttributeMultiprocessorCount, dev);
    hipOccupancyMaxActiveBlocksPerMultiprocessor(&per_cu, fwd_megakernel, 256, 0);
    if (per_cu > 2) per_cu = 2;
    if (per_cu < 1) per_cu = 1;
    grid_blocks = cus * per_cu;
  }
  P p{};
  const float** f = (const float**)&p;
  for (int i = 0; i < 37; i++) f[i] = (const float*)d_in[i];
  p.out = (float*)d_out;
  char* w = (char*)d_ws;
  size_t off = 0;
  auto take = [&](size_t bytes) { char* r = w + off; off += (bytes + 255) & ~(size_t)255; return r; };
  p.x = (float*)take((size_t)NT * DM * 4);
  p.mod = (float*)take((size_t)4 * 3 * 9216 * 4);
  p.lbr = (float*)take(16384 * 4);
  p.lbi = (float*)take(16384 * 4);
  p.bbr = (float*)take(16384 * 16 * 4);
  p.bbi = (float*)take(16384 * 16 * 4);
  p.proj = (float*)take((size_t)NT * INWP * 4);
  p.xbc = (float*)take((size_t)NT * 768 * 4);
  p.qkv = (float*)take((size_t)NT * 1536 * 4);
  p.dtv = (float*)take((size_t)NT * 16 * 4);
  p.dAv = (float*)take((size_t)NT * 16 * 4);
  p.betav = (float*)take((size_t)NT * 8 * 4);
  p.agv = (float*)take((size_t)NT * 8 * 4);
  p.qkd = (float*)take((size_t)NT * 4 * 4);
  p.s5y = (float*)take((size_t)2 * NT * 512 * 4);
  p.ssdy = (float*)take((size_t)2 * NT * 512 * 4);
  p.dny = (float*)take((size_t)2 * NT * 512 * 4);
  p.wt_wi = (bfraw*)take((size_t)2 * 5632 * 1024 * 2);
  p.wt_wo = (bfraw*)take((size_t)2 * 1024 * 2816 * 2);
  p.wt_win = (bfraw*)take((size_t)INWP * 1024 * 2);
  p.wt_glu = (bfraw*)take((size_t)2 * 1024 * 512 * 2);
  p.wt_ssdo = (bfraw*)take((size_t)1024 * 512 * 2);
  p.wt_dno = (bfraw*)take((size_t)1024 * 512 * 2);
  p.wt_wout = (bfraw*)take((size_t)1024 * 1024 * 2);
  (void)take(WT_SET * 2);
  p.h = (bfraw*)take((size_t)NT * DM * 2);
  p.act = (bfraw*)take((size_t)NT * DFF * 2);
  p.a_s5 = (bfraw*)take((size_t)NT * 512 * 2);
  p.a_ssd = (bfraw*)take((size_t)NT * 512 * 2);
  p.a_dn = (bfraw*)take((size_t)NT * 512 * 2);
  p.dn_u = (float*)take((size_t)1536 * 32 * 128 * 4);
  p.dn_ac = (float*)take((size_t)1536 * 4);
  p.dn_w = (bfraw*)take((size_t)1536 * 32 * 128 * 2);
  p.dn_qa = (bfraw*)take((size_t)1536 * 32 * 128 * 2);
  p.dn_kwt = (bfraw*)take((size_t)1536 * 128 * 32 * 2);
  p.dn_qkd = (bfraw*)take((size_t)1536 * 32 * 32 * 2);
  p.ssd_ac = (float*)take((size_t)NT * 16 * 4);
  p.ctr = (int*)take(256);
  p.bar = (unsigned*)take(XCD_BAR_WORDS * 4);
  hipMemsetAsync(p.bar, 0, XCD_BAR_WORDS * 4, stream);
  if (off > ws_size) fprintf(stderr, "workspace too small: need %zu have %zu\n", off, ws_size);
  void* args[] = {&p};
  hipError_t e = hipLaunchCooperativeKernel((void*)fwd_megakernel, dim3(grid_blocks), dim3(256), args, 0, stream);
  if (e != hipSuccess) fprintf(stderr, "cooperative launch failed: %s (grid %d)\n", hipGetErrorString(e), grid_blocks);
}
```
